# Optimizing an MI355X kernel written in HIP

```python
import math
import jax, jax.numpy as jnp
from jax import lax
import numpy as np

D_MODEL = 1024
BATCH = 4
SEQ = 4096
DEPTH = 1

EPS = 1e-6
ROPE_THETA = 10000.0
GLA_HEADS = 4
GLA_DK = 128
GLA_DV = 256
GLA_RANK = 16
GLA_TAU = 16.0
GLA_CHUNK = 64
GLA_QK = GLA_HEADS * GLA_DK
GLA_V = GLA_HEADS * GLA_DV
DIL_GROUPS = ((128, 1), (512, 4), (2048, 16))
DIL_HEADS = 4
DIL_HD = 128
DIL_BLOCK = 128
DIL_QK = len(DIL_GROUPS) * DIL_HEADS * DIL_HD
DIL_OUT = DIL_HEADS * DIL_HD
IN_SPLIT_SIZES = (GLA_QK, GLA_QK, GLA_V, GLA_V, GLA_RANK,
                  DIL_QK, DIL_QK, DIL_QK, DIL_OUT,
                  D_MODEL, D_MODEL)
IN_WIDTH = sum(IN_SPLIT_SIZES)

kernel_name = 'hybrid_gla_dilated_gated_merge'


def rms_norm(x, gain):
    xf = x.astype(jnp.float32)
    y = xf * lax.rsqrt(jnp.mean(xf * xf, axis=-1, keepdims=True) + EPS)
    return (y * gain.astype(jnp.float32)).astype(x.dtype)


def apply_rope(x, positions):
    half = x.shape[-1] // 2
    inv_freq = ROPE_THETA ** (-jnp.arange(half, dtype=jnp.float32) / half)
    ang = positions.astype(jnp.float32)[..., None] * inv_freq
    cos = jnp.cos(ang)[:, :, None, :]
    sin = jnp.sin(ang)[:, :, None, :]
    xf = x.astype(jnp.float32)
    x1, x2 = xf[..., :half], xf[..., half:]
    return jnp.concatenate([x1 * cos - x2 * sin, x2 * cos + x1 * sin], axis=-1).astype(x.dtype)


def gla_chunked(q, k, v, log_a):
    B, S, H, DK = q.shape
    DV = v.shape[-1]
    C = GLA_CHUNK
    N = S // C

    def chunks(t):
        return t.astype(jnp.float32).reshape(B, N, C, H, t.shape[-1]).transpose(0, 3, 1, 2, 4)

    qc = chunks(q) * (DK ** -0.5)
    kc, vc, gc = chunks(k), chunks(v), chunks(log_a)
    b = jnp.cumsum(gc, axis=3)
    b_last = b[:, :, :, -1:, :]
    q_t = qc * jnp.exp(b)
    k_t = kc * jnp.exp(-b)
    k_end = kc * jnp.exp(b_last - b)
    causal = jnp.tril(jnp.ones((C, C), dtype=bool))
    attn = jnp.where(causal, jnp.einsum('bhnid,bhnjd->bhnij', q_t, k_t), 0.0)
    o_intra = jnp.einsum('bhnij,bhnjv->bhniv', attn, vc)
    kv = jnp.einsum('bhnjd,bhnjv->bhndv', k_end, vc)
    decay = jnp.exp(b_last[:, :, :, 0, :])

    def step(state, inp):
        d, kvn = inp
        return d[..., None] * state + kvn, state

    s0 = jnp.zeros((B, H, DK, DV), jnp.float32)
    _, s_in = lax.scan(step, s0, (jnp.moveaxis(decay, 2, 0), jnp.moveaxis(kv, 2, 0)))
    o_inter = jnp.einsum('bhnid,nbhdv->bhniv', q_t, s_in)
    o = (o_intra + o_inter).transpose(0, 2, 3, 1, 4).reshape(B, S, H, DV)
    return o


def banded_window_attn(q, k, v, win, blk):
    N, L, H, D = q.shape
    nb = L // blk
    nprev = -(-win // blk)
    K = (nprev + 1) * blk
    pad = ((0, 0), (nprev * blk, 0), (0, 0), (0, 0))
    kb = jnp.pad(k, pad).reshape(N, nb + nprev, blk, H, D)
    vb = jnp.pad(v, pad).reshape(N, nb + nprev, blk, H, D)
    kw = jnp.concatenate([kb[:, j:j + nb] for j in range(nprev + 1)], axis=2)
    vw = jnp.concatenate([vb[:, j:j + nb] for j in range(nprev + 1)], axis=2)
    qb = q.reshape(N, nb, blk, H, D)
    s = jnp.einsum('nbqhd,nbkhd->nbhqk', qb, kw).astype(jnp.float32) * (D ** -0.5)
    qi = jnp.arange(blk)
    kj = jnp.arange(K)
    rel = qi[:, None] + nprev * blk - kj[None, :]
    kabs = jnp.arange(nb)[:, None] * blk - nprev * blk + kj[None, :]
    mask = ((rel >= 0) & (rel <= win))[None, :, :] & (kabs >= 0)[:, None, :]
    s = jnp.where(mask[None, :, None], s, -jnp.inf)
    m = jnp.max(s, axis=-1, keepdims=True)
    p = jnp.exp(s - m)
    l = jnp.sum(p, axis=-1, keepdims=True)
    o = jnp.einsum('nbhqk,nbkhd->nbqhd', p, vw.astype(jnp.float32))
    o = o / jnp.swapaxes(l, 2, 3)
    lse = jnp.swapaxes((m + jnp.log(l))[..., 0], 2, 3)
    return o.reshape(N, L, H, D), lse.reshape(N, L, H)


def dilated_group_attn(q, k, v, win, dil):
    B, S, H, D = q.shape
    L = S // dil
    Lp = -(-L // DIL_BLOCK) * DIL_BLOCK

    def to_sub(t):
        t = t.reshape(B, L, dil, H, D).transpose(0, 2, 1, 3, 4).reshape(B * dil, L, H, D)
        return jnp.pad(t, ((0, 0), (0, Lp - L), (0, 0), (0, 0)))

    o, lse = banded_window_attn(to_sub(q), to_sub(k), to_sub(v), win // dil, DIL_BLOCK)
    o = o[:, :L].reshape(B, dil, L, H, D).transpose(0, 2, 1, 3, 4).reshape(B, S, H, D)
    lse = lse[:, :L].reshape(B, dil, L, H).transpose(0, 2, 1, 3).reshape(B, S, H)
    return o, lse


def setup_inputs(seed: int = 0) -> dict:
    key = jax.random.key(seed)
    ks = jax.random.split(key, 12)
    f32 = jnp.float32
    x = jax.random.normal(ks[0], (BATCH, SEQ, D_MODEL), f32)
    positions = jnp.broadcast_to(jnp.arange(SEQ, dtype=jnp.int32), (BATCH, SEQ))
    norm_gain = 1.0 + 0.02 * jax.random.normal(ks[1], (DEPTH, D_MODEL), f32)
    w_in = jax.random.normal(ks[2], (DEPTH, D_MODEL, IN_WIDTH), f32) * D_MODEL ** -0.5
    gla_w_a2 = jax.random.normal(ks[3], (DEPTH, GLA_RANK, GLA_QK), f32) * GLA_RANK ** -0.5
    gla_b_a = 0.1 * jax.random.normal(ks[4], (DEPTH, GLA_QK), f32)
    gla_out_gain = 1.0 + 0.02 * jax.random.normal(ks[5], (DEPTH, GLA_DV), f32)
    dil_q_gain = 1.0 + 0.02 * jax.random.normal(ks[6], (DEPTH, DIL_HD), f32)
    dil_k_gain = 1.0 + 0.02 * jax.random.normal(ks[7], (DEPTH, DIL_HD), f32)
    w_gla_out = jax.random.normal(ks[8], (DEPTH, GLA_V, D_MODEL), f32) * GLA_V ** -0.5
    w_dil_out = jax.random.normal(ks[9], (DEPTH, DIL_OUT, D_MODEL), f32) * DIL_OUT ** -0.5
    w_o = jax.random.normal(ks[10], (DEPTH, D_MODEL, D_MODEL), f32) * D_MODEL ** -0.5
    return {'x': x, 'positions': positions, 'norm_gain': norm_gain, 'w_in': w_in,
            'gla_w_a2': gla_w_a2, 'gla_b_a': gla_b_a, 'gla_out_gain': gla_out_gain,
            'dil_q_gain': dil_q_gain, 'dil_k_gain': dil_k_gain,
            'w_gla_out': w_gla_out, 'w_dil_out': w_dil_out, 'w_o': w_o}


def reference(x, positions, norm_gain, w_in, gla_w_a2, gla_b_a, gla_out_gain,
              dil_q_gain, dil_k_gain, w_gla_out, w_dil_out, w_o):
    B, S, _ = x.shape
    offsets = np.cumsum(IN_SPLIT_SIZES)[:-1].tolist()
    n_groups = len(DIL_GROUPS)
    for layer in range(DEPTH):
        h = rms_norm(x, norm_gain[layer])
        proj = h @ w_in[layer]
        (q_a, k_a, v_a, r_a, a_lr, q_d, k_d, v_d, z_d, g_a, g_d) = jnp.split(proj, offsets, axis=-1)

        log_a = jax.nn.log_sigmoid((a_lr @ gla_w_a2[layer] + gla_b_a[layer]).astype(jnp.float32)) / GLA_TAU
        o_a = gla_chunked(q_a.reshape(B, S, GLA_HEADS, GLA_DK),
                          k_a.reshape(B, S, GLA_HEADS, GLA_DK),
                          v_a.reshape(B, S, GLA_HEADS, GLA_DV),
                          log_a.reshape(B, S, GLA_HEADS, GLA_DK))
        o_a = rms_norm(o_a, gla_out_gain[layer]).reshape(B, S, GLA_V)
        o_a = (o_a * jax.nn.silu(r_a.astype(jnp.float32))).astype(x.dtype)
        y_a = o_a @ w_gla_out[layer]

        n_heads_d = n_groups * DIL_HEADS
        qd = apply_rope(rms_norm(q_d.reshape(B, S, n_heads_d, DIL_HD), dil_q_gain[layer]), positions)
        kd = apply_rope(rms_norm(k_d.reshape(B, S, n_heads_d, DIL_HD), dil_k_gain[layer]), positions)
        vd = v_d.reshape(B, S, n_heads_d, DIL_HD)
        outs, lses = [], []
        for g, (win, dil) in enumerate(DIL_GROUPS):
            hs = slice(g * DIL_HEADS, (g + 1) * DIL_HEADS)
            o_g, lse_g = dilated_group_attn(qd[:, :, hs], kd[:, :, hs], vd[:, :, hs], win, dil)
            outs.append(o_g)
            lses.append(lse_g)
        wts = jax.nn.softmax(jnp.stack(lses, axis=0), axis=0)
        o_d = jnp.sum(wts[..., None] * jnp.stack(outs, axis=0), axis=0).reshape(B, S, DIL_OUT)
        o_d = (o_d * jax.nn.silu(z_d.astype(jnp.float32))).astype(x.dtype)
        y_d = o_d @ w_dil_out[layer]

        y = jax.nn.sigmoid(g_a) * y_a + jax.nn.sigmoid(g_d) * y_d
        x = x + (y @ w_o[layer]).astype(x.dtype)
    return x
```

```cpp
#include <hip/hip_runtime.h>
#include <hip/hip_cooperative_groups.h>
namespace cg = cooperative_groups;

#define LAS __attribute__((address_space(3)))
#define DI __device__ __forceinline__
typedef unsigned short bf16_t;
typedef short bf16x8 __attribute__((ext_vector_type(8)));
typedef short s16x4 __attribute__((ext_vector_type(4)));
typedef float f32x2 __attribute__((ext_vector_type(2)));
typedef float f32x4 __attribute__((ext_vector_type(4)));
typedef float f32x16 __attribute__((ext_vector_type(16)));
typedef unsigned u32x4 __attribute__((ext_vector_type(4)));
typedef unsigned u32x2 __attribute__((ext_vector_type(2)));
typedef __bf16 bf16x2v __attribute__((ext_vector_type(2)));

struct Params {
  const float* x; const int* pos; const float* norm_gain; const float* w_in; const float* w_a2; const float* b_a;
  const float* gla_gain; const float* qg; const float* kg; const float* w_go; const float* w_do; const float* w_o;
  unsigned char* ws; unsigned char* out;
};

#define MB(v) ((size_t)(v) << 20)
#define VAT_LD 16448
#define VDT_LD 4160
#define P_HN(p)    ((bf16_t*)((p).ws + MB(0)))
#define P_Y(p)     ((bf16_t*)((p).ws + MB(0)))
#define P_WINTB(p) ((bf16_t*)((p).ws + MB(32)))
#define P_W2T(p)   ((bf16_t*)((p).ws + MB(38)))
#define P_WOT(p)   ((bf16_t*)((p).ws + MB(41)))
#define P_BL(p)    ((float*)((p).ws + MB(43)))
#define P_CNT(p)   ((unsigned*)((p).ws + MB(43) + 786432))
#define P_A2(p)    ((bf16_t*)((p).ws + MB(44)))
#define P_QD(p)    ((bf16_t*)((p).ws + MB(92)))
#define P_KD(p)    ((bf16_t*)((p).ws + MB(140)))
#define P_VDT(p)   ((bf16_t*)((p).ws + MB(188)))
#define P_ZD(p)    ((bf16_t*)((p).ws + MB(237)))
#define P_QT(p)    ((bf16_t*)((p).ws + MB(92)))
#define P_KT(p)    ((bf16_t*)((p).ws + MB(108)))
#define P_VAT(p)   ((bf16_t*)((p).ws + MB(124)))
#define P_SFRAG(p) ((bf16_t*)((p).ws + MB(188)))
#define P_BCUM(p)  ((float*)((p).out + MB(0)))
#define P_WINTG(p) ((bf16_t*)((p).out + MB(32)))
#define P_WINTD(p) ((bf16_t*)((p).out + MB(36)))
#define P_CS(p)    ((unsigned*)((p).out + MB(46)))
#define P_OG0(p)   ((bf16_t*)((p).out + MB(0)))
#define P_OG1(p)   ((bf16_t*)((p).out + MB(16)))
#define P_LSE0(p)  ((float*)((p).out + MB(32)))
#define P_LSE1(p)  ((float*)((p).out + MB(32) + 262144))
#define P_OG2(p)   ((bf16_t*)((p).out + MB(33)))
#define P_LSE2(p)  ((float*)((p).out + MB(32) + 524288))
#define P_GA(p)    ((bf16_t*)((p).out + MB(0)))
#define P_GD(p)    ((bf16_t*)((p).out + MB(32)))

DI unsigned pk(float a, float b) { f32x2 v = {a, b}; bf16x2v r = __builtin_convertvector(v, bf16x2v); return __builtin_bit_cast(unsigned, r); }
DI float h_lo(unsigned u) { return (float)__builtin_bit_cast(_Float16, (unsigned short)(u & 0xffffu)); }
DI float h_hi(unsigned u) { return (float)__builtin_bit_cast(_Float16, (unsigned short)(u >> 16)); }
DI float bf_lo(unsigned u) { return __uint_as_float(u << 16); }
DI float bf_hi(unsigned u) { return __uint_as_float(u & 0xffff0000u); }
DI float fast_exp(float x) { return __builtin_amdgcn_exp2f(x * 1.4426950408889634f); }
DI int lane_id() { return (int)__builtin_amdgcn_mbcnt_hi(~0u, __builtin_amdgcn_mbcnt_lo(~0u, 0u)); }
DI float wave_sum(float v) {
#pragma unroll
  for (int o = 32; o; o >>= 1) v += __shfl_xor(v, o);
  return v;
}
DI float sigmoidf_(float x) { return __builtin_amdgcn_rcpf(1.0f + fast_exp(-x)); }
DI float siluf_(float x) { return x * __builtin_amdgcn_rcpf(1.0f + fast_exp(-x)); }
#define MFMA32(a, b, c) __builtin_amdgcn_mfma_f32_32x32x16_bf16((a), (b), (c), 0, 0, 0)
DI int crow(int reg, int h) { return (reg & 3) + 8 * (reg >> 2) + 4 * h; }
DI bf16x8 cat4(s16x4 lo, s16x4 hi) { return __builtin_shufflevector(lo, hi, 0, 1, 2, 3, 4, 5, 6, 7); }
DI bf16x8 pack8(const f32x16& x, int s) {
  u32x4 w;
  w.x = pk(x[8 * s + 0], x[8 * s + 1]); w.y = pk(x[8 * s + 2], x[8 * s + 3]); w.z = pk(x[8 * s + 4], x[8 * s + 5]); w.w = pk(x[8 * s + 6], x[8 * s + 7]);
  return __builtin_bit_cast(bf16x8, w);
}

DI void grid_barrier(unsigned* cnt, unsigned target, int wid) {
  asm volatile("s_waitcnt vmcnt(0) lgkmcnt(0)" ::: "memory");
  __syncthreads();
  if (wid == 0 && lane_id() == 0) {
    __builtin_amdgcn_fence(__ATOMIC_RELEASE, "agent");
    asm volatile("s_waitcnt vmcnt(0)" ::: "memory");
    __hip_atomic_fetch_add(cnt, 1u, __ATOMIC_RELAXED, __HIP_MEMORY_SCOPE_AGENT);
    while (__hip_atomic_load(cnt, __ATOMIC_RELAXED, __HIP_MEMORY_SCOPE_AGENT) < target) __builtin_amdgcn_s_sleep(2);
    __builtin_amdgcn_fence(__ATOMIC_ACQUIRE, "agent");
    asm volatile("s_waitcnt vmcnt(0)" ::: "memory");
  }
  __syncthreads();
}

#define XB_TMO      128
#define XB_XCNT(j)  (256  + 64 * (j))
#define XB_XSUB(j)  (1280 + 64 * (j))
#define XB_XGEN(j)  (2304 + 64 * (j))
#define XB_TOP      3328
#define XB_TOPGEN   3392
#define XB_SPIN_CAP (1u << 18)
DI unsigned xb_ld(unsigned* p)              { return __hip_atomic_load(p, __ATOMIC_RELAXED, __HIP_MEMORY_SCOPE_AGENT); }
DI unsigned xb_add(unsigned* p, unsigned v) { return __hip_atomic_fetch_add(p, v, __ATOMIC_RELAXED, __HIP_MEMORY_SCOPE_AGENT); }
DI unsigned xb_xcc_id() { return (unsigned)__builtin_amdgcn_s_getreg((3 << 11) | 20) & 0xFu; }
#define XB_SPIN(cond, bar) do { unsigned _sp = 0; while (cond) { __builtin_amdgcn_s_sleep(1); \
    if ((++_sp & 255u) == 0u) { if (xb_ld(&(bar)[XB_TMO])) break; if (_sp > XB_SPIN_CAP) { atomicAdd(&(bar)[XB_TMO], 1u); break; } } } } while (0)
struct XcdBarrier { unsigned* bar; unsigned x; volatile LAS unsigned* st; };
DI XcdBarrier xcd_barrier_post(unsigned* bar, volatile LAS unsigned* st, const bool leader) {
  XcdBarrier b; b.bar = bar; b.x = xb_xcc_id(); b.st = st;
  if (leader) (void)xb_add(&bar[XB_XCNT(b.x)], 1u);
  return b;
}
DI void xcd_barrier_complete(unsigned* bar, unsigned x, unsigned& nloc, unsigned& nx) {
  const unsigned G = gridDim.x;
  unsigned sum, cnt, mine, sp = 0u;
  for (;;) {
    sum = 0u; cnt = 0u; mine = 0u;
#pragma unroll
    for (unsigned j = 0; j < 16; ++j) { const unsigned c = xb_ld(&bar[XB_XCNT(j)]); sum += c; cnt += (c > 0u) ? 1u : 0u; mine = (j == x) ? c : mine; }
    if (sum == G) break;
    __builtin_amdgcn_s_sleep(1);
    if ((++sp & 255u) == 0u) { if (xb_ld(&bar[XB_TMO])) break; if (sp > XB_SPIN_CAP) { atomicAdd(&bar[XB_TMO], 1u); break; } }
  }
  nloc = mine > 0u ? mine : 1u; nx = cnt > 0u ? cnt : 1u;
}
DI void xcd_barrier(const XcdBarrier& b, const int wid) {
  asm volatile("s_waitcnt vmcnt(0) lgkmcnt(0)" ::: "memory");
  __syncthreads();
  if (wid == 0 && lane_id() == 0) {
    unsigned* bar = b.bar;
    __builtin_amdgcn_s_waitcnt(0);
    unsigned nloc = b.st[0], nx = b.st[1];
    if (nloc == 0u) { xcd_barrier_complete(bar, b.x, nloc, nx); b.st[0] = nloc; b.st[1] = nx; }
    const unsigned old = xb_add(&bar[XB_XSUB(b.x)], 1u);
    const unsigned gen = old / nloc;
    if (old + 1u == (gen + 1u) * nloc) {
      __builtin_amdgcn_fence(__ATOMIC_RELEASE, "agent");
      asm volatile("s_waitcnt vmcnt(0)" ::: "memory");
      const unsigned og = xb_add(&bar[XB_TOP], 1u);
      const unsigned tg = og / nx;
      if (og + 1u == (tg + 1u) * nx) xb_add(&bar[XB_TOPGEN], 1u);
      else XB_SPIN(xb_ld(&bar[XB_TOPGEN]) == tg, bar);
      __builtin_amdgcn_fence(__ATOMIC_ACQUIRE, "agent");
      xb_add(&bar[XB_XGEN(b.x)], 1u);
      asm volatile("s_waitcnt vmcnt(0)" ::: "memory");
    } else {
      XB_SPIN(xb_ld(&bar[XB_XGEN(b.x)]) == gen, bar);
      __builtin_amdgcn_fence(__ATOMIC_ACQUIRE, "agent");
      asm volatile("s_waitcnt vmcnt(0)" ::: "memory");
    }
  }
  __syncthreads();
}

DI void conv_tile(const Params& p, LAS unsigned char* ldsb, int idx, const int wid) {
  int tid = wid * 64 + lane_id(); asm volatile("" : "+v"(tid));
  const float* src; int ld_src, sc; bf16_t* dst; int ld_dst, drow, dk0 = 0, rg, kb;
  if (idx < 512) { rg = idx >> 3; kb = idx & 7; const int n = rg * 32; src = p.w_in; ld_src = 10256; sc = n; dst = P_WINTG(p); ld_dst = 1024; drow = n; }
  else if (idx < 1792) { const int i = idx - 512; rg = i >> 3; kb = i & 7; const int n = rg * 32; src = p.w_in; ld_src = 10256; dst = P_WINTD(p); ld_dst = 1024; drow = n;
    if (n < 3072) { const int seg = n >= 1536; const int nn = n - seg * 1536; const int tq = nn >> 8, pp = nn & 255; const int wc = (pp >> 5) & 3, bj = pp >> 7;
      const int f = 128 * (wc >> 1) + 64 * bj + 32 * (wc & 1); sc = (seg ? 4624 : 3088) + 256 * tq + f; }
    else if (n < 4608) sc = 6160 + (n - 3072); else sc = 7696 + (n - 4608); }
  else if (idx < 2560) { const int i = idx - 1792; rg = i >> 3; kb = i & 7; const int n = rg * 32; src = p.w_in; ld_src = 10256; dst = P_WINTB(p); ld_dst = 1024; drow = n;
    sc = n < 1024 ? 2048 + n : (n < 2048 ? 8208 + (n - 1024) : 9232 + (n - 2048)); }
  else if (idx < 2816) { const int i = idx - 2560; rg = i >> 3; kb = i & 7; src = p.w_go; ld_src = 1024; sc = rg * 32; dst = P_W2T(p); ld_dst = 1536; drow = rg * 32; }
  else if (idx < 2944) { const int i = idx - 2816; rg = i >> 2; kb = i & 3; src = p.w_do; ld_src = 1024; sc = rg * 32; dst = P_W2T(p); ld_dst = 1536; drow = rg * 32; dk0 = 1024; }
  else { const int i = idx - 2944; rg = i >> 3; kb = i & 7; src = p.w_o; ld_src = 1024; sc = rg * 32; dst = P_WOT(p); ld_dst = 1024; drow = rg * 32; }
  const int k0 = kb * 128;
  LAS float* tl = (LAS float*)ldsb;
#pragma unroll
  for (int e = 0; e < 2; ++e) {
    const int kk = (tid >> 3) + 64 * e, c4 = 4 * (tid & 7);
    const f32x4 v = *(const f32x4*)(src + (size_t)(k0 + kk) * ld_src + sc + c4);
    tl[kk * 33 + c4 + 0] = v[0]; tl[kk * 33 + c4 + 1] = v[1]; tl[kk * 33 + c4 + 2] = v[2]; tl[kk * 33 + c4 + 3] = v[3];
  }
  __syncthreads();
  {
    const int nn = tid >> 4, kp = (tid & 15) * 8;
    float v[8];
#pragma unroll
    for (int e = 0; e < 8; ++e) v[e] = tl[(kp + e) * 33 + nn];
    u32x4 w; w.x = pk(v[0], v[1]); w.y = pk(v[2], v[3]); w.z = pk(v[4], v[5]); w.w = pk(v[6], v[7]);
    *(u32x4*)(dst + (size_t)(drow + nn) * ld_dst + dk0 + k0 + kp) = w;
  }
  __syncthreads();
}

DI void conv_wave_tile(const Params& p, LAS unsigned char* ldsb, int idx, int lane) {
  asm volatile("" : "+v"(lane));
  const float* src; int ld_src, sc; bf16_t* dst; int ld_dst, drow, dk0 = 0, rg, kb;
  if (idx < 2560) { rg = idx >> 4; kb = idx & 15; const int n = rg * 32; src = p.w_in; ld_src = 10256; dst = P_WINTD(p); ld_dst = 1024; drow = n;
    if (n < 3072) { const int seg = n >= 1536; const int nn = n - seg * 1536; const int tq = nn >> 8, pp = nn & 255; const int wc = (pp >> 5) & 3, bj = pp >> 7;
      const int f = 128 * (wc >> 1) + 64 * bj + 32 * (wc & 1); sc = (seg ? 4624 : 3088) + 256 * tq + f; }
    else if (n < 4608) sc = 6160 + (n - 3072); else sc = 7696 + (n - 4608); }
  else if (idx < 4096) { const int i = idx - 2560; rg = i >> 4; kb = i & 15; const int n = rg * 32; src = p.w_in; ld_src = 10256; dst = P_WINTB(p); ld_dst = 1024; drow = n;
    sc = n < 1024 ? 2048 + n : (n < 2048 ? 8208 + (n - 1024) : 9232 + (n - 2048)); }
  else if (idx < 4608) { const int i = idx - 4096; rg = i >> 4; kb = i & 15; src = p.w_go; ld_src = 1024; sc = rg * 32; dst = P_W2T(p); ld_dst = 1536; drow = rg * 32; }
  else if (idx < 4864) { const int i = idx - 4608; rg = i >> 3; kb = i & 7; src = p.w_do; ld_src = 1024; sc = rg * 32; dst = P_W2T(p); ld_dst = 1536; drow = rg * 32; dk0 = 1024; }
  else { const int i = idx - 4864; rg = i >> 4; kb = i & 15; src = p.w_o; ld_src = 1024; sc = rg * 32; dst = P_WOT(p); ld_dst = 1024; drow = rg * 32; }
  const int k0 = kb * 64;
  LAS float* tl = (LAS float*)ldsb;
  f32x4 v[8];
#pragma unroll
  for (int e = 0; e < 8; ++e) v[e] = *(const f32x4*)(src + (size_t)(k0 + (lane >> 3) + 8 * e) * ld_src + sc + 4 * (lane & 7));
#pragma unroll
  for (int e = 0; e < 8; ++e) { const int kk = (lane >> 3) + 8 * e, c4 = 4 * (lane & 7); tl[kk * 33 + c4 + 0] = v[e][0]; tl[kk * 33 + c4 + 1] = v[e][1]; tl[kk * 33 + c4 + 2] = v[e][2]; tl[kk * 33 + c4 + 3] = v[e][3]; }
  asm volatile("s_waitcnt lgkmcnt(0)" ::: "memory");
  const int nn = lane >> 1, kh = (lane & 1) * 32;
  bf16_t* drp = dst + (size_t)(drow + nn) * ld_dst + dk0 + k0 + kh;
#pragma unroll
  for (int q = 0; q < 4; ++q) {
    float t[8];
#pragma unroll
    for (int e = 0; e < 8; ++e) t[e] = tl[(kh + 8 * q + e) * 33 + nn];
    u32x4 w; w.x = pk(t[0], t[1]); w.y = pk(t[2], t[3]); w.z = pk(t[4], t[5]); w.w = pk(t[6], t[7]);
    *(u32x4*)(drp + 8 * q) = w;
  }
  asm volatile("s_waitcnt lgkmcnt(0)" ::: "memory");
}

DI void rope_chunk(const Params& p, const int c, const int t384) {
#pragma unroll 1
  for (int idx = t384; idx < 4096; idx += 384) {
    const int t = idx >> 6, i = idx & 63; const size_t token = (size_t)c * 64 + t;
    double inv = 1.0;
    if (i & 1) inv *= 0.8659643233600653; if (i & 2) inv *= 0.7498942093324558; if (i & 4) inv *= 0.5623413251903491;
    if (i & 8) inv *= 0.31622776601683794; if (i & 16) inv *= 0.09999999999999999; if (i & 32) inv *= 0.009999999999999998;
    const float angf = (float)p.pos[token] * (float)inv;
    const double a = (double)angf; const double q = rint(a * 0.6366197723675814);
    double y = fma(-q, 1.5707963267948966, a); y = fma(-q, 6.123233995736766e-17, y);
    const double y2 = y * y;
    double sp = 1.0 / 6227020800.0; sp = sp * y2 - 1.0 / 39916800.0; sp = sp * y2 + 1.0 / 362880.0; sp = sp * y2 - 1.0 / 5040.0; sp = sp * y2 + 1.0 / 120.0; sp = sp * y2 - 1.0 / 6.0; sp = sp * y2 * y + y;
    double cp = -1.0 / 87178291200.0; cp = cp * y2 + 1.0 / 479001600.0; cp = cp * y2 - 1.0 / 3628800.0; cp = cp * y2 + 1.0 / 40320.0; cp = cp * y2 - 1.0 / 720.0; cp = cp * y2 + 1.0 / 24.0; cp = cp * y2 - 0.5; cp = cp * y2 + 1.0;
    const int iq = ((int)q) & 3;
    const double sv = (iq == 0) ? sp : (iq == 1) ? cp : (iq == 2) ? -sp : -cp;
    const double cv = (iq == 0) ? cp : (iq == 1) ? -sp : (iq == 2) ? -cp : sp;
    const _Float16 hc = (_Float16)(float)cv, hsn = (_Float16)(float)sv;
    P_CS(p)[token * 64 + i] = (unsigned)__builtin_bit_cast(unsigned short, hc) | ((unsigned)__builtin_bit_cast(unsigned short, hsn) << 16);
  }
}

DI void phase0(const Params& p, LAS unsigned char* lds, const int wid) {
  int lane = lane_id(); asm volatile("" : "+v"(lane));
  const int tid = wid * 64 + lane;
  LAS bf16_t* hs = (LAS bf16_t*)lds;
  LAS bf16_t* w16s = (LAS bf16_t*)(lds + 66048);
  LAS float* alr = (LAS float*)(lds + 99072);
  LAS unsigned char* tl = lds + 103168;
  for (int c = blockIdx.x; c < 256; c += gridDim.x) {
    f32x4 vv[2][4][4];
#pragma unroll
    for (int ps = 0; ps < 2; ++ps)
#pragma unroll
      for (int rr = 0; rr < 4; ++rr)
#pragma unroll
        for (int j = 0; j < 4; ++j) vv[ps][rr][j] = *(const f32x4*)(p.x + ((size_t)c * 64 + ps * 32 + wid * 4 + rr) * 1024 + 256 * j + 4 * lane);
    if (c == (int)blockIdx.x)
      for (int idx = tid; idx < 16384; idx += 512) { const int k = idx >> 4, cc = idx & 15; const float wv = p.w_in[(size_t)k * 10256 + 3072 + cc]; w16s[cc * 1032 + k] = (bf16_t)(pk(wv, 0.f) & 0xffffu); }
#pragma unroll
    for (int ps = 0; ps < 2; ++ps) {
      f32x4 (&v)[4][4] = vv[ps];
#pragma unroll
      for (int rr = 0; rr < 4; ++rr) {
        const int lrow = wid * 4 + rr; const size_t token = (size_t)c * 64 + ps * 32 + lrow;
        float ss = 0.f;
#pragma unroll
        for (int j = 0; j < 4; ++j) ss += v[rr][j][0] * v[rr][j][0] + v[rr][j][1] * v[rr][j][1] + v[rr][j][2] * v[rr][j][2] + v[rr][j][3] * v[rr][j][3];
        ss = wave_sum(ss);
        const float rstd = __builtin_amdgcn_rsqf(ss * (1.0f / 1024.0f) + 1e-6f);
#pragma unroll
        for (int j = 0; j < 4; ++j) {
          const f32x4 g = *(const f32x4*)(p.norm_gain + 256 * j + 4 * lane);
          u32x2 w; w.x = pk(v[rr][j][0] * rstd * g[0], v[rr][j][1] * rstd * g[1]); w.y = pk(v[rr][j][2] * rstd * g[2], v[rr][j][3] * rstd * g[3]);
          *(u32x2*)(P_HN(p) + token * 1024 + 256 * j + 4 * lane) = w;
          *(LAS u32x2*)(hs + lrow * 1032 + 256 * j + 4 * lane) = w;
        }
      }
      __syncthreads();
      if (wid < 2) {
        f32x4 acc = {0.f, 0.f, 0.f, 0.f};
        const int m = lane & 15, kq = lane >> 4;
#pragma unroll 4
        for (int s = 0; s < 32; ++s) {
          const bf16x8 a = *(const LAS bf16x8*)(hs + (16 * wid + m) * 1032 + 32 * s + 8 * kq);
          const bf16x8 b = *(const LAS bf16x8*)(w16s + m * 1032 + 32 * s + 8 * kq);
          acc = __builtin_amdgcn_mfma_f32_16x16x32_bf16(a, b, acc, 0, 0, 0);
        }
#pragma unroll
        for (int i = 0; i < 4; ++i) alr[(32 * ps + 16 * wid + 4 * kq + i) * 16 + m] = acc[i];
      }
      __syncthreads();
    }
    {
      float wa[16];
#pragma unroll
      for (int r = 0; r < 16; ++r) wa[r] = p.w_a2[r * 512 + tid];
      const float bias = p.b_a[tid];
      float run = 0.f; float* bc = P_BCUM(p) + (size_t)c * 64 * 512 + tid;
#pragma unroll 2
      for (int t = 0; t < 64; ++t) {
        float z = bias;
#pragma unroll
        for (int r4 = 0; r4 < 4; ++r4) { const f32x4 av = *(const LAS f32x4*)(alr + t * 16 + 4 * r4); z += av[0] * wa[4 * r4] + av[1] * wa[4 * r4 + 1] + av[2] * wa[4 * r4 + 2] + av[3] * wa[4 * r4 + 3]; }
        const float ls = fminf(z, 0.f) - 0.6931471805599453f * __builtin_amdgcn_logf(1.0f + fast_exp(-fabsf(z)));
        run += ls * 0.0625f;
        bc[(size_t)t * 512] = run;
      }
      P_BL(p)[c * 512 + tid] = run;
    }
    __syncthreads();
  }
  for (int idx = blockIdx.x; idx < 512; idx += gridDim.x) conv_tile(p, tl, idx, wid);
}

constexpr int BM = 256, BK = 64, HALF = 128, HTB = HALF * BK * 2, NXCD = 8, WGM = 8;
DI int lds_byte(int r, int c) { const int st = (r >> 4) * 2 + (c >> 5), rr = r & 15, cc = c & 31, ob = rr * 64 + cc * 2; return st * 1024 + (ob ^ (((ob >> 9) & 1) << 5)); }
DI void stage_rc(int b, int& R, int& C) { const int st = b / 1024, sb = b % 1024, swz = sb ^ (((sb >> 9) & 1) << 5); R = (st >> 1) * 16 + swz / 64; C = (st & 1) * 32 + (swz % 64) / 2; }
DI int perm32(int rho) { const int n = rho >> 4, i = rho & 15; return 8 * (i >> 2) + 4 * n + (i & 3); }
DI int tokmap(int v, int rho) { return v == 0 ? rho : (v == 1 ? (((rho & 63) << 2) + (rho >> 6)) : (((rho & 15) << 4) + (rho >> 4))); }
struct Unit { int pm, pn; };
struct StaticOrder {
  int nM, nN, nwg, G, c;
  DI void init(int nM_, int nN_, int G_, int c_) { nM = nM_; nN = nN_; nwg = nM * nN; G = G_; c = c_; }
  DI bool next(int i, Unit& u) const {
    const long L = (long)i * G + c; if (L >= nwg) return false;
    int wgid = (int)L; { const int q = nwg / NXCD, r = nwg % NXCD, xcd = wgid % NXCD, off = wgid / NXCD; wgid = (xcd < r ? xcd * (q + 1) : r * (q + 1) + (xcd - r) * q) + off; }
    const int nig = WGM * nN, gid = wgid / nig, fm = gid * WGM, gsz = (nM - fm) < WGM ? (nM - fm) : WGM;
    u.pm = fm + ((wgid % nig) % gsz); u.pn = (wgid % nig) / gsz; return true;
  }
};

template <int PH> struct Epi {
  static constexpr bool VARIANTS = (PH == 2), HAS_MID = (PH == 4);
  Params p;
  DI void setup(const Unit& u, int K, const char*& row, const char*& col, int& var) const {
    const size_t tstep = (size_t)256 * K * 2; var = 0;
    if (PH == 1) { const char* w = (const char*)P_WINTG(p) + u.pn * tstep; const char* h = (const char*)P_HN(p) + u.pm * tstep; if (u.pn < 4) { row = h; col = w; } else { row = w; col = h; } }
    else if (PH == 2) { const char* w = (const char*)P_WINTD(p) + u.pn * tstep; const char* h = (const char*)P_HN(p) + u.pm * tstep;
      if (u.pn >= 12 && u.pn < 18) { row = w; col = h; var = (u.pn - 12) >> 1; } else if (u.pn < 20) { row = h; col = w; } else { row = h; col = (const char*)P_WINTB(p) + (u.pn - 20) * tstep; } }
    else if (PH == 3) { row = (const char*)P_HN(p) + u.pm * tstep; col = (const char*)P_WINTB(p) + (4 + u.pn) * tstep; }
    else if (PH == 4) { row = (const char*)P_A2(p) + u.pm * tstep; col = (const char*)P_W2T(p) + u.pn * tstep; }
    else { row = (const char*)P_Y(p) + u.pm * tstep; col = (const char*)P_WOT(p) + u.pn * tstep; }
  }
  DI void mid(f32x4 (&acc)[2][2][4][2], const Unit& u, int wr, int wc, int fr, int fq) const {
    asm volatile("" : "+v"(fr), "+v"(fq));
#pragma unroll
    for (int ai = 0; ai < 2; ++ai)
#pragma unroll
      for (int m = 0; m < 4; ++m)
#pragma unroll
        for (int bj = 0; bj < 2; ++bj) {
          const size_t off = (size_t)(u.pm * 256 + ai * 128 + wr * 64 + m * 16 + fr) * 1024 + u.pn * 256 + bj * 128 + wc * 32 + fq * 8;
          const u32x4 a = *(const u32x4*)(P_GA(p) + off), d = *(const u32x4*)(P_GD(p) + off);
          acc[ai][bj][m][0][0] *= bf_lo(a.x) * __builtin_amdgcn_rcpf(bf_lo(d.x)); acc[ai][bj][m][0][1] *= bf_hi(a.x) * __builtin_amdgcn_rcpf(bf_hi(d.x));
          acc[ai][bj][m][0][2] *= bf_lo(a.y) * __builtin_amdgcn_rcpf(bf_lo(d.y)); acc[ai][bj][m][0][3] *= bf_hi(a.y) * __builtin_amdgcn_rcpf(bf_hi(d.y));
          acc[ai][bj][m][1][0] *= bf_lo(a.z) * __builtin_amdgcn_rcpf(bf_lo(d.z)); acc[ai][bj][m][1][1] *= bf_hi(a.z) * __builtin_amdgcn_rcpf(bf_hi(d.z));
          acc[ai][bj][m][1][2] *= bf_lo(a.w) * __builtin_amdgcn_rcpf(bf_lo(d.w)); acc[ai][bj][m][1][3] *= bf_hi(a.w) * __builtin_amdgcn_rcpf(bf_hi(d.w));
        }
  }
  DI void operator()(f32x4 (&acc)[2][2][4][2], const Unit& u, int wr, int wc, int fr, int fq, LAS unsigned char* lds) const {
    asm volatile("" : "+v"(fr), "+v"(fq));
    const bool qkd = (PH == 2) && (u.pn < 12);
    if (PH == 2 && qkd) {
      LAS float* Xs = (LAS float*)(lds + 131072);
      const bool isk = u.pn >= 6; const int tq = isk ? u.pn - 6 : u.pn; const int head = 2 * tq + (wc >> 1), lg = 2 * (tq >> 1);
      u32x4 csr[4][2];
#pragma unroll
      for (int m = 0; m < 4; ++m) {
        const int token = u.pm * 256 + wr * 64 + m * 16 + fr;
        const unsigned* cp = P_CS(p) + (size_t)token * 64 + 32 * (wc & 1) + 8 * fq;
        csr[m][0] = *(const u32x4*)cp; csr[m][1] = *(const u32x4*)(cp + 4);
      }
      float ssq[2][4];
#pragma unroll
      for (int ai = 0; ai < 2; ++ai)
#pragma unroll
        for (int m = 0; m < 4; ++m) {
          float s = 0.f;
#pragma unroll
          for (int bj = 0; bj < 2; ++bj)
#pragma unroll
            for (int n = 0; n < 2; ++n) { const f32x4 v = acc[ai][bj][m][n]; s += v[0] * v[0] + v[1] * v[1] + v[2] * v[2] + v[3] * v[3]; }
          s += __shfl_xor(s, 16); s += __shfl_xor(s, 32); ssq[ai][m] = s;
          if (fq == 0) Xs[(wr * 128 + (ai * 4 + m) * 16 + fr) * 4 + wc] = s;
        }
      asm volatile("s_waitcnt lgkmcnt(0)" ::: "memory"); __builtin_amdgcn_s_barrier(); asm volatile("" ::: "memory");
      const float* gp = (isk ? p.kg : p.qg) + 32 * (wc & 1) + 8 * fq;
      const f32x4 g00 = *(const f32x4*)(gp), g01 = *(const f32x4*)(gp + 4), g10 = *(const f32x4*)(gp + 64), g11 = *(const f32x4*)(gp + 68);
      bf16_t* dstb = isk ? P_KD(p) : P_QD(p);
#pragma unroll
      for (int ai = 0; ai < 2; ++ai) {
        if (ai == 1) {
#pragma unroll
          for (int m = 0; m < 4; ++m) {
            const int token = u.pm * 256 + 128 + wr * 64 + m * 16 + fr;
            const unsigned* cp = P_CS(p) + (size_t)token * 64 + 32 * (wc & 1) + 8 * fq;
            csr[m][0] = *(const u32x4*)cp; csr[m][1] = *(const u32x4*)(cp + 4);
          }
        }
#pragma unroll
        for (int m = 0; m < 4; ++m) {
          const float tot = ssq[ai][m] + Xs[(wr * 128 + (ai * 4 + m) * 16 + fr) * 4 + (wc ^ 1)];
          const float rstd = __builtin_amdgcn_rsqf(tot * (1.0f / 128.0f) + 1e-6f);
          const int token = u.pm * 256 + ai * 128 + wr * 64 + m * 16 + fr; const int b = token >> 12, s = token & 4095;
          const int dil = 1 << lg, r = s & (dil - 1), uu = s >> lg, L = 4096 >> lg;
          const u32x4 ca = csr[m][0], cb = csr[m][1];
          const f32x4 c0 = {h_lo(ca.x), h_lo(ca.y), h_lo(ca.z), h_lo(ca.w)}, s0 = {h_hi(ca.x), h_hi(ca.y), h_hi(ca.z), h_hi(ca.w)};
          const f32x4 c1 = {h_lo(cb.x), h_lo(cb.y), h_lo(cb.z), h_lo(cb.w)}, s1 = {h_hi(cb.x), h_hi(cb.y), h_hi(cb.z), h_hi(cb.w)};
          const f32x4 x1a = acc[ai][0][m][0] * rstd * g00, x1b = acc[ai][0][m][1] * rstd * g01, x2a = acc[ai][1][m][0] * rstd * g10, x2b = acc[ai][1][m][1] * rstd * g11;
          const f32x4 o1a = x1a * c0 - x2a * s0, o1b = x1b * c1 - x2b * s1, o2a = x2a * c0 + x1a * s0, o2b = x2b * c1 + x1b * s1;
          bf16_t* drow = dstb + ((size_t)(b * 12 + head) * 4096 + r * L + uu) * 128 + 32 * (wc & 1) + 8 * fq;
          u32x4 w; w.x = pk(o1a[0], o1a[1]); w.y = pk(o1a[2], o1a[3]); w.z = pk(o1b[0], o1b[1]); w.w = pk(o1b[2], o1b[3]); *(u32x4*)drow = w;
          w.x = pk(o2a[0], o2a[1]); w.y = pk(o2a[2], o2a[3]); w.z = pk(o2b[0], o2b[1]); w.w = pk(o2b[2], o2b[3]); *(u32x4*)(drow + 64) = w;
        }
      }
      return;
    }
    constexpr bool SIDE_F = (PH == 1 || PH == 5), SIDE_U = (PH == 2 || PH == 4);
#pragma unroll
    for (int ai = 0; ai < 2; ++ai) {
      f32x4 sf0[SIDE_F ? 4 : 1][2], sf1[SIDE_F ? 4 : 1][2]; u32x4 su[SIDE_U ? 4 : 1][2];
#pragma unroll
      for (int m = 0; m < 4; ++m)
#pragma unroll
        for (int bj = 0; bj < 2; ++bj) {
          const int row_l = ai * 128 + wr * 64 + m * 16 + fr, col_l = bj * 128 + wc * 32 + fq * 8;
          if (PH == 1 && u.pn < 4) { const float* bp = P_BCUM(p) + ((size_t)u.pm * 256 + row_l) * 512 + (u.pn & 1) * 256 + col_l; sf0[SIDE_F ? m : 0][bj] = *(const f32x4*)bp; sf1[SIDE_F ? m : 0][bj] = *(const f32x4*)(bp + 4); }
          if (PH == 5) { const float* xp = p.x + ((size_t)u.pm * 256 + row_l) * 1024 + u.pn * 256 + col_l; sf0[SIDE_F ? m : 0][bj] = *(const f32x4*)xp; sf1[SIDE_F ? m : 0][bj] = *(const f32x4*)(xp + 4); }
          if (PH == 2 && u.pn >= 20) su[SIDE_U ? m : 0][bj] = *(const u32x4*)(P_A2(p) + ((size_t)u.pm * 256 + row_l) * 1536 + (u.pn - 20) * 256 + col_l);
          if (PH == 4) su[SIDE_U ? m : 0][bj] = *(const u32x4*)(P_GD(p) + ((size_t)u.pm * 256 + row_l) * 1024 + u.pn * 256 + col_l);
        }
#pragma unroll
      for (int m = 0; m < 4; ++m)
#pragma unroll
        for (int bj = 0; bj < 2; ++bj) {
          const int row_l = ai * 128 + wr * 64 + m * 16 + fr, col_l = bj * 128 + wc * 32 + fq * 8;
          f32x4 v0 = acc[ai][bj][m][0], v1 = acc[ai][bj][m][1];
          if (PH == 1) {
            if (u.pn < 4) {
              const size_t token = (size_t)u.pm * 256 + row_l; const int fc = (u.pn & 1) * 256 + col_l;
              const f32x4 b0 = sf0[SIDE_F ? m : 0][bj], b1 = sf1[SIDE_F ? m : 0][bj];
              const bool isq = u.pn < 2; const float sc = isq ? 0.08838834764831845f : 1.0f, sg = isq ? 1.0f : -1.0f;
#pragma unroll
              for (int j = 0; j < 4; ++j) { v0[j] *= sc * fast_exp(sg * b0[j]); v1[j] *= sc * fast_exp(sg * b1[j]); }
              u32x4 w; w.x = pk(v0[0], v0[1]); w.y = pk(v0[2], v0[3]); w.z = pk(v1[0], v1[1]); w.w = pk(v1[2], v1[3]);
              *(u32x4*)((isq ? P_QT(p) : P_KT(p)) + token * 512 + fc) = w;
            } else {
              const int f = (u.pn - 4) * 256 + row_l; const size_t token = (size_t)u.pm * 256 + col_l;
              u32x4 w; w.x = pk(v0[0], v0[1]); w.y = pk(v0[2], v0[3]); w.z = pk(v1[0], v1[1]); w.w = pk(v1[2], v1[3]);
              *(u32x4*)(P_VAT(p) + (size_t)f * VAT_LD + token) = w;
            }
          } else if (PH == 2) {
            if (u.pn < 18) {
              const int tv = u.pn - 12, f = tv * 256 + row_l, head = f >> 7, d = f & 127, var = tv >> 1, lg = 2 * var;
              const int token = u.pm * 256 + tokmap(var, col_l); const int b = token >> 12, s = token & 4095;
              const int dil = 1 << lg, r = s & (dil - 1), uu = s >> lg, L = 4096 >> lg;
              u32x4 w; w.x = pk(v0[0], v0[1]); w.y = pk(v0[2], v0[3]); w.z = pk(v1[0], v1[1]); w.w = pk(v1[2], v1[3]);
              *(u32x4*)(P_VDT(p) + ((size_t)(b * 12 + head) * 128 + d) * VDT_LD + r * L + uu) = w;
            } else if (u.pn < 20) {
              const size_t token = (size_t)u.pm * 256 + row_l; const int fc = (u.pn - 18) * 256 + col_l;
              u32x4 w; w.x = pk(siluf_(v0[0]), siluf_(v0[1])); w.y = pk(siluf_(v0[2]), siluf_(v0[3])); w.z = pk(siluf_(v1[0]), siluf_(v1[1])); w.w = pk(siluf_(v1[2]), siluf_(v1[3]));
              *(u32x4*)(P_ZD(p) + token * 512 + fc) = w;
            } else {
              const size_t token = (size_t)u.pm * 256 + row_l;
              bf16_t* ap = P_A2(p) + token * 1536 + (u.pn - 20) * 256 + col_l; const u32x4 a = su[SIDE_U ? m : 0][bj];
              u32x4 w; w.x = pk(bf_lo(a.x) * siluf_(v0[0]), bf_hi(a.x) * siluf_(v0[1])); w.y = pk(bf_lo(a.y) * siluf_(v0[2]), bf_hi(a.y) * siluf_(v0[3]));
              w.z = pk(bf_lo(a.z) * siluf_(v1[0]), bf_hi(a.z) * siluf_(v1[1])); w.w = pk(bf_lo(a.w) * siluf_(v1[2]), bf_hi(a.w) * siluf_(v1[3]));
              *(u32x4*)ap = w;
            }
          } else if (PH == 3) {
            const size_t token = (size_t)u.pm * 256 + row_l;
            bf16_t* gp = (u.pn < 4 ? P_GA(p) : P_GD(p)) + token * 1024 + (u.pn & 3) * 256 + col_l;
            u32x4 w; w.x = pk(sigmoidf_(v0[0]), sigmoidf_(v0[1])); w.y = pk(sigmoidf_(v0[2]), sigmoidf_(v0[3])); w.z = pk(sigmoidf_(v1[0]), sigmoidf_(v1[1])); w.w = pk(sigmoidf_(v1[2]), sigmoidf_(v1[3]));
            *(u32x4*)gp = w;
          } else if (PH == 4) {
            const size_t off = ((size_t)u.pm * 256 + row_l) * 1024 + u.pn * 256 + col_l; const u32x4 d = su[SIDE_U ? m : 0][bj];
            u32x4 w; w.x = pk(v0[0] * bf_lo(d.x), v0[1] * bf_hi(d.x)); w.y = pk(v0[2] * bf_lo(d.y), v0[3] * bf_hi(d.y)); w.z = pk(v1[0] * bf_lo(d.z), v1[1] * bf_hi(d.z)); w.w = pk(v1[2] * bf_lo(d.w), v1[3] * bf_hi(d.w));
            *(u32x4*)(P_Y(p) + off) = w;
          } else {
            const size_t off = ((size_t)u.pm * 256 + row_l) * 1024 + u.pn * 256 + col_l;
            const f32x4 x0 = sf0[SIDE_F ? m : 0][bj], x1 = sf1[SIDE_F ? m : 0][bj];
            *(f32x4*)((float*)p.out + off) = x0 + v0; *(f32x4*)((float*)p.out + off + 4) = x1 + v1;
          }
        }
    }
  }
};

template <int PH>
DI void gemm_phase(LAS unsigned char* lds, const int K, const int nN, const Epi<PH>& E, const int wid) {
  int lane = lane_id(); asm volatile("" : "+v"(lane));
  const int tid = wid * 64 + lane, wr = wid >> 2, wc = wid & 3, fr = lane & 15, fq = lane >> 4;
  const int nt = K / BK;
  constexpr int NV = Epi<PH>::VARIANTS ? 3 : 1;
  unsigned voffA[2], voffB[NV][2];
#pragma unroll
  for (int i = 0; i < 2; ++i) { int R, C; stage_rc(tid * 16 + i * 8192, R, C); const int Rb = (R & ~31) + perm32(R & 31);
    voffA[i] = (unsigned)(R * K + C) * 2u;
#pragma unroll
    for (int v = 0; v < NV; ++v) voffB[v][i] = (unsigned)(tokmap(v, Rb) * K + C) * 2u; }
  const size_t kstep = (size_t)(BK * 2);
  const size_t hstepA = (size_t)HALF * K * 2;
  const unsigned ldsw = (unsigned)wid * 1024u;
  const int aoff = lds_byte(wr * 64 + fr, fq * 8), boff = lds_byte(wc * 32 + fr, fq * 8);
#define G_SA(b, h) (((b) * 2 + (h)) * HTB)
#define G_SB(b, h) ((4 + (b) * 2 + (h)) * HTB)
#define G_STAGE(bufoff, gbase, v0_, v1_) do { \
    __builtin_amdgcn_global_load_lds((const unsigned*)((const char*)(gbase) + (v0_)), (LAS unsigned*)(lds + (bufoff) + ldsw), 16, 0, 0); \
    __builtin_amdgcn_global_load_lds((const unsigned*)((const char*)(gbase) + (v1_)), (LAS unsigned*)(lds + (bufoff) + ldsw + 8192), 16, 0, 0); } while (0)
#define G_STAGEA(bufoff, gbase) G_STAGE(bufoff, gbase, voffA[0], voffA[1])
#define G_LDA(dst, b, h) do { _Pragma("unroll") for (int m = 0; m < 4; ++m) _Pragma("unroll") for (int k = 0; k < 2; ++k) dst[m][k] = *(const LAS bf16x8*)(lds + G_SA(b, h) + aoff + m * 2048 + k * 1024); } while (0)
#define G_LDB(dst, b, h) do { _Pragma("unroll") for (int n = 0; n < 2; ++n) _Pragma("unroll") for (int k = 0; k < 2; ++k) dst[n][k] = *(const LAS bf16x8*)(lds + G_SB(b, h) + boff + n * 2048 + k * 1024); } while (0)
#define G_MMA(ai, bj, At, Bt) do { __builtin_amdgcn_s_setprio(1); _Pragma("unroll") for (int m = 0; m < 4; ++m) _Pragma("unroll") for (int n = 0; n < 2; ++n) _Pragma("unroll") for (int k = 0; k < 2; ++k) \
    acc[ai][bj][m][n] = __builtin_amdgcn_mfma_f32_16x16x32_bf16(Bt[n][k], At[m][k], acc[ai][bj][m][n], 0, 0, 0); __builtin_amdgcn_s_setprio(0); } while (0)
#define G_WAIT_V(n) asm volatile("s_waitcnt vmcnt(" #n ")" ::: "memory")
#define G_WAIT_L(n) asm volatile("s_waitcnt lgkmcnt(" #n ")" ::: "memory")
#define G_BAR __builtin_amdgcn_s_barrier()
#define G_SCHED __builtin_amdgcn_sched_barrier(0)
  StaticOrder S; S.init(64, PH == 3 ? 4 : nN, gridDim.x, blockIdx.x);
  auto nextu = [&](int k, Unit& u) __attribute__((always_inline)) -> bool {
    if (PH == 3) { if (!S.next(k >> 1, u)) return false; u.pn += 4 * (k & 1); return true; }
    return S.next(k, u);
  };
  Unit cur, nxt; int ui = 0;
  if (!nextu(0, cur)) return;
  f32x4 acc[2][2][4][2];
#pragma unroll
  for (int a = 0; a < 2; ++a)
#pragma unroll
    for (int b = 0; b < 2; ++b)
#pragma unroll
      for (int m = 0; m < 4; ++m)
#pragma unroll
        for (int n = 0; n < 2; ++n) acc[a][b][m][n] = (f32x4){0.f, 0.f, 0.f, 0.f};
  bf16x8 At[4][2], B0[2][2], B1[2][2];
  const char* cA; const char* cB; int cvar;
  E.setup(cur, K, cA, cB, cvar);
  unsigned cv0 = voffB[0][0], cv1 = voffB[0][1]; size_t chB = hstepA;
  if (Epi<PH>::VARIANTS) { if (cvar == 1) { cv0 = voffB[NV > 1 ? 1 : 0][0]; cv1 = voffB[NV > 1 ? 1 : 0][1]; chB = (size_t)2 * K * 2; } else if (cvar == 2) { cv0 = voffB[NV > 2 ? 2 : 0][0]; cv1 = voffB[NV > 2 ? 2 : 0][1]; chB = (size_t)8 * K * 2; } }
  G_STAGE(G_SB(0, 0), cB, cv0, cv1); G_STAGEA(G_SA(0, 0), cA); G_STAGE(G_SB(0, 1), cB + chB, cv0, cv1); G_STAGEA(G_SA(0, 1), cA + hstepA);
  if (wr == 1) G_BAR;
  G_WAIT_V(4); G_BAR;
  G_STAGE(G_SB(1, 0), cB + kstep, cv0, cv1); G_STAGEA(G_SA(1, 0), cA + kstep); G_STAGE(G_SB(1, 1), cB + chB + kstep, cv0, cv1);
  G_WAIT_V(6); G_BAR;
  for (;;) {
    const bool has_next = nextu(ui + 1, nxt);
    const char* nA = cA; const char* nB = cB; int nvar = cvar;
    if (has_next) E.setup(nxt, K, nA, nB, nvar);
    unsigned nv0 = voffB[0][0], nv1 = voffB[0][1]; size_t nhB = hstepA;
    if (Epi<PH>::VARIANTS) { if (nvar == 1) { nv0 = voffB[NV > 1 ? 1 : 0][0]; nv1 = voffB[NV > 1 ? 1 : 0][1]; nhB = (size_t)2 * K * 2; } else if (nvar == 2) { nv0 = voffB[NV > 2 ? 2 : 0][0]; nv1 = voffB[NV > 2 ? 2 : 0][1]; nhB = (size_t)8 * K * 2; } }
    for (int t = 0; t < nt; t += 2) {
      const bool last = (t == nt - 2);
      if (Epi<PH>::HAS_MID && t == 16) E.mid(acc, cur, wr, wc, fr, fq);
      const char* a1 = cA + (size_t)(t + 1) * kstep;
      const char* a2 = last ? nA : cA + (size_t)(t + 2) * kstep; const char* b2 = last ? nB : cB + (size_t)(t + 2) * kstep;
      const char* a3 = a2 + kstep; const char* b3 = b2 + kstep;
      const unsigned bv0 = last ? nv0 : cv0, bv1 = last ? nv1 : cv1; const size_t bh = last ? nhB : chB;
      G_LDB(B0, 0, 0); G_SCHED; G_LDA(At, 0, 0); G_STAGEA(G_SA(1, 1), a1 + hstepA);
      G_WAIT_L(8); G_BAR; G_WAIT_L(0); G_MMA(0, 0, At, B0); G_BAR; G_SCHED;
      G_LDB(B1, 0, 1); G_STAGE(G_SB(0, 0), b2, bv0, bv1);
      G_BAR; G_WAIT_L(0); G_MMA(0, 1, At, B1); G_BAR;
      G_LDA(At, 0, 1); G_STAGEA(G_SA(0, 0), a2);
      G_BAR; G_WAIT_L(0); G_MMA(1, 0, At, B0); G_BAR; G_SCHED;
      G_STAGE(G_SB(0, 1), b2 + bh, bv0, bv1);
      G_WAIT_V(6); G_BAR; G_MMA(1, 1, At, B1); G_BAR;
      G_LDB(B0, 1, 0); G_SCHED; G_LDA(At, 1, 0); G_STAGEA(G_SA(0, 1), a2 + hstepA);
      G_WAIT_L(8); G_BAR; G_WAIT_L(0); G_MMA(0, 0, At, B0); G_BAR; G_SCHED;
      G_LDB(B1, 1, 1); G_STAGE(G_SB(1, 0), b3, bv0, bv1);
      G_BAR; G_WAIT_L(0); G_MMA(0, 1, At, B1); G_BAR;
      G_LDA(At, 1, 1); G_STAGEA(G_SA(1, 0), a3);
      G_BAR; G_WAIT_L(0); G_MMA(1, 0, At, B0); G_BAR; G_SCHED;
      G_STAGE(G_SB(1, 1), b3 + bh, bv0, bv1);
      G_WAIT_V(6); G_BAR; G_MMA(1, 1, At, B1); G_BAR;
    }
    E(acc, cur, wr, wc, fr, fq, lds);
    if (!has_next) break;
#pragma unroll
    for (int a = 0; a < 2; ++a)
#pragma unroll
      for (int b = 0; b < 2; ++b)
#pragma unroll
        for (int m = 0; m < 4; ++m)
#pragma unroll
          for (int n = 0; n < 2; ++n) acc[a][b][m][n] = (f32x4){0.f, 0.f, 0.f, 0.f};
    cur = nxt; cA = nA; cB = nB; cvar = nvar; cv0 = nv0; cv1 = nv1; chB = nhB; ++ui;
  }
  G_WAIT_V(0);
  if (wr == 0) G_BAR;
  G_BAR;
}

DI void gla_scan_item(const Params& p, LAS unsigned char* img, int item, int lane) {
  asm volatile("" : "+v"(lane));
  const int dvs = item & 7, dkt = (item >> 3) & 3, bh = item >> 5, b = bh >> 2, h = bh & 3;
  const int hh = lane >> 5, c = lane & 31;
  const char* ktb = (const char*)(P_KT(p) + ((size_t)b * 4096) * 512 + h * 128 + dkt * 32);
  const char* vab = (const char*)(P_VAT(p) + (size_t)(h * 256 + dvs * 32) * VAT_LD + (size_t)b * 4096);
  const char* blb = (const char*)(P_BL(p) + (size_t)(b * 64) * 512 + h * 128 + dkt * 32);
  const unsigned kto = (unsigned)(((lane >> 2) * 512 + (lane & 3) * 8) * 2), vao = (unsigned)((c * VAT_LD + 8 * hh) * 2), blo = (unsigned)(4 * hh * 4);
  u32x4* sf = (u32x4*)P_SFRAG(p) + (((size_t)(bh * 64) * 32 + dkt * 8 + dvs) * 64 + lane) * 2;
  const unsigned wbase = (unsigned)(size_t)img + (unsigned)((lane >> 2) * 64 + (lane & 3) * 16);
  const int i16 = lane & 15, q = i16 >> 2, pp = i16 & 3, blk = (lane >> 4) & 1;
  const unsigned rbase = (unsigned)(size_t)img + (unsigned)((8 * hh + q) * 64 + 8 * (4 * blk + pp));
  f32x16 S;
#pragma unroll
  for (int i = 0; i < 16; ++i) S[i] = 0.f;
  u32x4 kq0[4], kq1[4], kq2[4]; bf16x8 vq0[4], vq1[4], vq2[4]; f32x4 dq0[4], dq1[4], dq2[4];
  auto load_ops = [&](u32x4 (&kq)[4], bf16x8 (&vq)[4], f32x4 (&dq)[4], int n) __attribute__((always_inline)) {
#pragma unroll
    for (int e = 0; e < 4; ++e) {
      kq[e] = *(const u32x4*)(ktb + (size_t)(n * 64 + 16 * e) * 1024 + kto);
      vq[e] = *(const bf16x8*)(vab + (size_t)(n * 64 + 16 * e) * 2 + vao);
      dq[e] = *(const f32x4*)(blb + (size_t)(n * 512 + 8 * e) * 4 + blo);
    }
  };
  auto step = [&](u32x4 (&kq)[4], bf16x8 (&vq)[4], f32x4 (&dq)[4], int n) __attribute__((always_inline)) {
#pragma unroll
    for (int e = 0; e < 4; ++e) *(LAS u32x4*)(size_t)(wbase + e * 1024) = kq[e];
    {
      u32x4 w0, w1;
      w0.x = pk(S[0], S[1]); w0.y = pk(S[2], S[3]); w0.z = pk(S[4], S[5]); w0.w = pk(S[6], S[7]);
      w1.x = pk(S[8], S[9]); w1.y = pk(S[10], S[11]); w1.z = pk(S[12], S[13]); w1.w = pk(S[14], S[15]);
      u32x4* d = sf + (size_t)n * 4096; d[0] = w0; d[1] = w1;
    }
    s16x4 t0, t1, t2, t3, t4, t5, t6, t7;
    asm volatile("s_waitcnt lgkmcnt(0)\n\t"
                 "ds_read_b64_tr_b16 %0, %8\n\tds_read_b64_tr_b16 %1, %8 offset:256\n\t"
                 "ds_read_b64_tr_b16 %2, %8 offset:1024\n\tds_read_b64_tr_b16 %3, %8 offset:1280\n\t"
                 "ds_read_b64_tr_b16 %4, %8 offset:2048\n\tds_read_b64_tr_b16 %5, %8 offset:2304\n\t"
                 "ds_read_b64_tr_b16 %6, %8 offset:3072\n\tds_read_b64_tr_b16 %7, %8 offset:3328\n\t"
                 "s_waitcnt lgkmcnt(0)"
                 : "=&v"(t0), "=&v"(t1), "=&v"(t2), "=&v"(t3), "=&v"(t4), "=&v"(t5), "=&v"(t6), "=&v"(t7) : "v"(rbase) : "memory");
    f32x16 D, D2;
#pragma unroll
    for (int i = 0; i < 16; ++i) { D[i] = 0.f; D2[i] = 0.f; }
    D = MFMA32(cat4(t0, t1), vq[0], D); D2 = MFMA32(cat4(t4, t5), vq[2], D2); D = MFMA32(cat4(t2, t3), vq[1], D); D2 = MFMA32(cat4(t6, t7), vq[3], D2);
#pragma unroll
    for (int i = 0; i < 16; ++i) S[i] = (S[i] + (D[i] + D2[i])) * fast_exp(dq[i >> 2][i & 3]);
    if (n + 3 < 64) load_ops(kq, vq, dq, n + 3);
  };
  load_ops(kq0, vq0, dq0, 0); load_ops(kq1, vq1, dq1, 1); load_ops(kq2, vq2, dq2, 2);
#pragma unroll 1
  for (int n = 0; n < 63; n += 3) { step(kq0, vq0, dq0, n); step(kq1, vq1, dq1, n + 1); step(kq2, vq2, dq2, n + 2); }
  step(kq0, vq0, dq0, 63);
}

DI void gla_out_item(const Params& p, LAS unsigned char* wl, int item, int lane) {
  asm volatile("" : "+v"(lane));
  const int th = item & 1, n = (item >> 1) & 63, bh = item >> 7, b = bh >> 2, h = bh & 3;
  const int hh = lane >> 5, c = lane & 31;
  const size_t tok0 = (size_t)b * 4096 + n * 64;
  f32x16 o[8];
#pragma unroll
  for (int d = 0; d < 8; ++d)
#pragma unroll
    for (int i = 0; i < 16; ++i) o[d][i] = 0.f;
  const bf16_t* qrow = P_QT(p) + (tok0 + 32 * th + c) * 512 + h * 128;
  {
    bf16x8 qn[8];
#pragma unroll
    for (int s = 0; s < 8; ++s) qn[s] = *(const bf16x8*)(qrow + 16 * s + 8 * hh);
#pragma unroll 1
    for (int tt = 0; tt <= th; ++tt) {
      const bf16_t* vgl = P_VAT(p) + (size_t)(h * 256 + (lane >> 2)) * VAT_LD + tok0 + 32 * tt + (lane & 3) * 8;
      u32x4 vst0[8], vst1[8];
#pragma unroll
      for (int e = 0; e < 8; ++e) { vst0[e] = *(const u32x4*)(vgl + (size_t)(16 * e) * VAT_LD); vst1[e] = *(const u32x4*)(vgl + (size_t)(128 + 16 * e) * VAT_LD); }
      const bf16_t* krow = P_KT(p) + (tok0 + 32 * tt + c) * 512 + h * 128;
      f32x16 a;
#pragma unroll
      for (int i = 0; i < 16; ++i) a[i] = 0.f;
#pragma unroll
      for (int s = 0; s < 8; ++s) a = MFMA32(*(const bf16x8*)(krow + 16 * s + 8 * hh), qn[s], a);
#pragma unroll
      for (int i = 0; i < 16; ++i) a[i] = (32 * tt + crow(i, hh) > 32 * th + c) ? 0.f : a[i];
      const bf16x8 pf0 = pack8(a, 0), pf1 = pack8(a, 1);
      const unsigned vwr = (unsigned)(size_t)wl + (unsigned)((lane >> 2) * 80 + (lane & 3) * 16), vrd = (unsigned)(size_t)wl + (unsigned)(c * 80 + 8 * hh);
#pragma unroll
      for (int half = 0; half < 2; ++half) {
#pragma unroll
        for (int e = 0; e < 8; ++e) *(LAS u32x4*)(size_t)(vwr + e * 1280) = half ? vst1[e] : vst0[e];
        asm volatile("s_waitcnt lgkmcnt(0)" ::: "memory");
#pragma unroll
        for (int d4 = 0; d4 < 4; ++d4) {
          const unsigned va = vrd + d4 * 2560;
          o[4 * half + d4] = MFMA32(cat4(*(const LAS s16x4*)(size_t)(va), *(const LAS s16x4*)(size_t)(va + 16)), pf0, o[4 * half + d4]);
          o[4 * half + d4] = MFMA32(cat4(*(const LAS s16x4*)(size_t)(va + 32), *(const LAS s16x4*)(size_t)(va + 48)), pf1, o[4 * half + d4]);
        }
        asm volatile("s_waitcnt lgkmcnt(0)" ::: "memory");
      }
    }
  }
  const bf16_t* sfb = P_SFRAG(p) + ((size_t)(bh * 64 + n) * 32 * 64 + lane) * 16;
#pragma unroll 1
  for (int dkt = 0; dkt < 4; ++dkt) {
#pragma unroll
    for (int s = 0; s < 2; ++s) {
      const bf16_t* qp = qrow + 32 * dkt + 16 * s + 4 * hh;
      const bf16x8 qf = cat4(*(const s16x4*)qp, *(const s16x4*)(qp + 8));
#pragma unroll
      for (int dvt = 0; dvt < 8; ++dvt) o[dvt] = MFMA32(*(const bf16x8*)(sfb + (size_t)(dkt * 8 + dvt) * 1024 + 8 * s), qf, o[dvt]);
    }
  }
  float ss = 0.f;
#pragma unroll
  for (int d = 0; d < 8; ++d)
#pragma unroll
    for (int i = 0; i < 16; ++i) ss += o[d][i] * o[d][i];
  ss += __shfl_xor(ss, 32);
  const float rstd = __builtin_amdgcn_rsqf(ss * (1.0f / 256.0f) + 1e-6f);
  const unsigned ow = (unsigned)(size_t)wl + (unsigned)(c * 528 + 8 * hh);
#pragma unroll
  for (int dvt = 0; dvt < 8; ++dvt)
#pragma unroll
    for (int g = 0; g < 4; ++g) {
      const int dv = 32 * dvt + 8 * g + 4 * hh; const f32x4 gn = *(const f32x4*)(p.gla_gain + dv);
      u32x2 w; w.x = pk(o[dvt][4 * g + 0] * rstd * gn[0], o[dvt][4 * g + 1] * rstd * gn[1]); w.y = pk(o[dvt][4 * g + 2] * rstd * gn[2], o[dvt][4 * g + 3] * rstd * gn[3]);
      *(LAS u32x2*)(size_t)(ow + (32 * dvt + 8 * g) * 2) = w;
    }
  asm volatile("s_waitcnt lgkmcnt(0)" ::: "memory");
  bf16_t* obase = P_A2(p) + (tok0 + 32 * th) * 1536 + h * 256 + (lane & 31) * 8;
#pragma unroll
  for (int e = 0; e < 16; ++e) {
    const int row = (lane >> 5) + 2 * e;
    const u32x4 w = *(const LAS u32x4*)(size_t)((unsigned)(size_t)wl + (unsigned)(row * 528 + (lane & 31) * 16));
    *(u32x4*)(obase + (size_t)row * 1536) = w;
  }
  asm volatile("s_waitcnt lgkmcnt(0)" ::: "memory");
}

template <bool MERGE>
DI void attn_group_item(const Params& p, LAS unsigned char* wl, int item, int lane, const int g) {
  asm volatile("" : "+v"(lane));
  const int lg = 2 * g, L = 4096 >> lg, njl = 7 - lg;
  const int j = item & ((1 << njl) - 1), r = (item >> njl) & ((1 << lg) - 1), h4 = (item >> 7) & 3, b = item >> 9;
  const int hh = lane >> 5, c = lane & 31, head = 4 * g + h4;
  const int ui = 32 * j + c;
  const size_t plane = (size_t)(b * 12 + head) * 4096;
  bf16x8 qf[8];
  const bf16_t* qg = P_QD(p) + (plane + r * L + 32 * j) * 128 + lane * 8;
  u32x4 qst[8];
#pragma unroll
  for (int e = 0; e < 8; ++e) qst[e] = *(const u32x4*)(qg + e * 512);
  const bf16_t* kg = P_KD(p) + (plane + r * L) * 128 + lane * 8;
  const bf16_t* vg = P_VDT(p) + ((size_t)(b * 12 + head) * 128 + (lane >> 2)) * VDT_LD + r * L + (lane & 3) * 8;
  const unsigned kw = (unsigned)(size_t)wl + (unsigned)((lane >> 4) * 272 + (lane & 15) * 16);
  const unsigned vw = (unsigned)(size_t)wl + 8704u + (unsigned)((lane >> 2) * 80 + (lane & 3) * 16);
  const unsigned kr = (unsigned)(size_t)wl + (unsigned)(c * 272 + 16 * hh);
  const unsigned vr = (unsigned)(size_t)wl + 8704u + (unsigned)(c * 80 + 8 * hh);
  const int kt0 = j >= 4 ? j - 4 : 0;
  u32x4 kst[8], vst[8];
#pragma unroll
  for (int e = 0; e < 8; ++e) { kst[e] = *(const u32x4*)(kg + (size_t)(32 * kt0) * 128 + e * 512); vst[e] = *(const u32x4*)(vg + (size_t)(e * 16) * VDT_LD + 32 * kt0); }
#pragma unroll
  for (int e = 0; e < 8; ++e) *(LAS u32x4*)(size_t)((unsigned)(size_t)wl + (unsigned)((lane >> 4) * 272 + (lane & 15) * 16) + e * 1088) = qst[e];
  asm volatile("s_waitcnt lgkmcnt(0)" ::: "memory");
#pragma unroll
  for (int s = 0; s < 8; ++s) qf[s] = *(const LAS bf16x8*)(size_t)((unsigned)(size_t)wl + (unsigned)(c * 272 + 16 * hh) + 32 * s);
  asm volatile("s_waitcnt lgkmcnt(0)" ::: "memory");
  f32x16 o[4];
#pragma unroll
  for (int d = 0; d < 4; ++d)
#pragma unroll
    for (int i = 0; i < 16; ++i) o[d][i] = 0.f;
  float m_run = -1e30f, l_run = 0.f;
#pragma unroll 1
  for (int kt = kt0; kt <= j; ++kt) {
#pragma unroll
    for (int e = 0; e < 8; ++e) { *(LAS u32x4*)(size_t)(kw + e * 1088) = kst[e]; *(LAS u32x4*)(size_t)(vw + e * 1280) = vst[e]; }
    if (kt < j) {
#pragma unroll
      for (int e = 0; e < 8; ++e) { kst[e] = *(const u32x4*)(kg + (size_t)(32 * (kt + 1)) * 128 + e * 512); vst[e] = *(const u32x4*)(vg + (size_t)(e * 16) * VDT_LD + 32 * (kt + 1)); }
    }
    asm volatile("s_waitcnt lgkmcnt(0)" ::: "memory");
    f32x16 sa, sb;
#pragma unroll
    for (int i = 0; i < 16; ++i) { sa[i] = 0.f; sb[i] = 0.f; }
#pragma unroll
    for (int s = 0; s < 4; ++s) { sa = MFMA32(*(const LAS bf16x8*)(size_t)(kr + 32 * s), qf[s], sa); sb = MFMA32(*(const LAS bf16x8*)(size_t)(kr + 32 * (s + 4)), qf[s + 4], sb); }
    float tmax = -1e30f;
    const bool interior = (kt >= j - 3) && (kt < j);
    if (interior) {
#pragma unroll
      for (int i = 0; i < 16; ++i) { const float sv = (sa[i] + sb[i]) * 0.12751743074602467f; sa[i] = sv; tmax = fmaxf(tmax, sv); }
    } else {
#pragma unroll
      for (int i = 0; i < 16; ++i) { const int key = 32 * kt + crow(i, hh); const bool valid = (key <= ui) && (key >= ui - 128); const float sv = valid ? (sa[i] + sb[i]) * 0.12751743074602467f : -1e30f; sa[i] = sv; tmax = fmaxf(tmax, sv); }
    }
    tmax = fmaxf(tmax, __shfl_xor(tmax, 32));
    const float m_new = fmaxf(m_run, tmax), alpha = __builtin_amdgcn_exp2f(m_run - m_new);
    float psum = 0.f;
    if (interior) {
#pragma unroll
      for (int i = 0; i < 16; ++i) { const float pv = __builtin_amdgcn_exp2f(sa[i] - m_new); psum += pv; sa[i] = pv; }
    } else {
#pragma unroll
      for (int i = 0; i < 16; ++i) { const float pv = (sa[i] > -1e29f) ? __builtin_amdgcn_exp2f(sa[i] - m_new) : 0.f; psum += pv; sa[i] = pv; }
    }
    psum += __shfl_xor(psum, 32);
    l_run = l_run * alpha + psum; m_run = m_new;
    if (__builtin_amdgcn_ballot_w64(alpha != 1.0f)) {
#pragma unroll
      for (int d = 0; d < 4; ++d)
#pragma unroll
        for (int i = 0; i < 16; ++i) o[d][i] *= alpha;
    }
    const bf16x8 pf0 = pack8(sa, 0), pf1 = pack8(sa, 1);
#pragma unroll
    for (int dt = 0; dt < 4; ++dt) {
      const unsigned va = vr + dt * 2560;
      o[dt] = MFMA32(cat4(*(const LAS s16x4*)(size_t)(va), *(const LAS s16x4*)(size_t)(va + 16)), pf0, o[dt]);
      o[dt] = MFMA32(cat4(*(const LAS s16x4*)(size_t)(va + 32), *(const LAS s16x4*)(size_t)(va + 48)), pf1, o[dt]);
    }
    asm volatile("s_waitcnt lgkmcnt(0)" ::: "memory");
  }
  const float inv = __builtin_amdgcn_rcpf(l_run);
  const float lse = 0.6931471805599453f * (m_run + __builtin_amdgcn_logf(l_run));
  const size_t token = (size_t)b * 4096 + r + ((size_t)ui << lg);
  if (!MERGE) {
    if (hh == 0) (g == 0 ? P_LSE0(p) : (g == 1 ? P_LSE1(p) : P_LSE2(p)))[token * 4 + h4] = lse;
    const unsigned ow = (unsigned)(size_t)wl + (unsigned)(c * 272 + 8 * hh);
#pragma unroll
    for (int dt = 0; dt < 4; ++dt)
#pragma unroll
      for (int q = 0; q < 4; ++q) {
        u32x2 w; w.x = pk(o[dt][4 * q + 0] * inv, o[dt][4 * q + 1] * inv); w.y = pk(o[dt][4 * q + 2] * inv, o[dt][4 * q + 3] * inv);
        *(LAS u32x2*)(size_t)(ow + (32 * dt + 8 * q) * 2) = w;
      }
    asm volatile("s_waitcnt lgkmcnt(0)" ::: "memory");
    bf16_t* obase = (g == 0 ? P_OG0(p) : (g == 1 ? P_OG1(p) : P_OG2(p))) + 128 * h4 + (lane & 15) * 8;
    const size_t tok0 = (size_t)b * 4096 + r + ((size_t)(32 * j) << lg);
#pragma unroll
    for (int e = 0; e < 8; ++e) {
      const int row = (lane >> 4) + 4 * e;
      const u32x4 w = *(const LAS u32x4*)(size_t)((unsigned)(size_t)wl + (unsigned)(row * 272 + (lane & 15) * 16));
      *(u32x4*)(obase + (tok0 + ((size_t)row << lg)) * 512) = w;
    }
    asm volatile("s_waitcnt lgkmcnt(0)" ::: "memory");
  } else {
    const float l0 = P_LSE0(p)[token * 4 + h4], l1 = P_LSE1(p)[token * 4 + h4];
    const float mx = fmaxf(fmaxf(l0, l1), lse);
    float w0 = fast_exp(l0 - mx), w1 = fast_exp(l1 - mx), w2 = fast_exp(lse - mx);
    const float wi = __builtin_amdgcn_rcpf(w0 + w1 + w2); w0 *= wi; w1 *= wi; w2 *= wi * inv;
    const bf16_t* o0 = P_OG0(p) + token * 512 + 128 * h4; const bf16_t* o1 = P_OG1(p) + token * 512 + 128 * h4;
    const bf16_t* zrow = P_ZD(p) + token * 512 + 128 * h4;
    bf16_t* orow = P_A2(p) + token * 1536 + 1024 + 128 * h4;
#pragma unroll
    for (int dt = 0; dt < 4; ++dt)
#pragma unroll
      for (int q = 0; q < 4; ++q) {
        const int d = 32 * dt + 8 * q + 4 * hh;
        const u32x2 z = *(const u32x2*)(zrow + d), a0 = *(const u32x2*)(o0 + d), a1 = *(const u32x2*)(o1 + d);
        const float r0 = (w0 * bf_lo(a0.x) + w1 * bf_lo(a1.x) + w2 * o[dt][4 * q + 0]) * bf_lo(z.x);
        const float r1 = (w0 * bf_hi(a0.x) + w1 * bf_hi(a1.x) + w2 * o[dt][4 * q + 1]) * bf_hi(z.x);
        const float r2 = (w0 * bf_lo(a0.y) + w1 * bf_lo(a1.y) + w2 * o[dt][4 * q + 2]) * bf_lo(z.y);
        const float r3 = (w0 * bf_hi(a0.y) + w1 * bf_hi(a1.y) + w2 * o[dt][4 * q + 3]) * bf_hi(z.y);
        u32x2 w; w.x = pk(r0, r1); w.y = pk(r2, r3);
        *(u32x2*)(orow + d) = w;
      }
  }
}

DI void attn_merge_pass(const Params& p, const int wid, int lane) {
  asm volatile("" : "+v"(lane));
  const int gw = blockIdx.x * 8 + wid, nw = gridDim.x * 8;
#pragma unroll 2
  for (int q = gw * 64 + lane; q < 65536 * 16; q += nw * 64) {
    const int R = q >> 4, dq = (q & 15) * 8;
    const float l0 = P_LSE0(p)[R], l1 = P_LSE1(p)[R], l2 = P_LSE2(p)[R];
    const u32x4 a0 = *(const u32x4*)(P_OG0(p) + (size_t)q * 8), a1 = *(const u32x4*)(P_OG1(p) + (size_t)q * 8), a2 = *(const u32x4*)(P_OG2(p) + (size_t)q * 8), z = *(const u32x4*)(P_ZD(p) + (size_t)q * 8);
    const float mx = fmaxf(fmaxf(l0, l1), l2);
    float w0 = fast_exp(l0 - mx), w1 = fast_exp(l1 - mx), w2 = fast_exp(l2 - mx);
    const float wi = __builtin_amdgcn_rcpf(w0 + w1 + w2); w0 *= wi; w1 *= wi; w2 *= wi;
    u32x4 w;
    w.x = pk((w0 * bf_lo(a0.x) + w1 * bf_lo(a1.x) + w2 * bf_lo(a2.x)) * bf_lo(z.x), (w0 * bf_hi(a0.x) + w1 * bf_hi(a1.x) + w2 * bf_hi(a2.x)) * bf_hi(z.x));
    w.y = pk((w0 * bf_lo(a0.y) + w1 * bf_lo(a1.y) + w2 * bf_lo(a2.y)) * bf_lo(z.y), (w0 * bf_hi(a0.y) + w1 * bf_hi(a1.y) + w2 * bf_hi(a2.y)) * bf_hi(z.y));
    w.z = pk((w0 * bf_lo(a0.z) + w1 * bf_lo(a1.z) + w2 * bf_lo(a2.z)) * bf_lo(z.z), (w0 * bf_hi(a0.z) + w1 * bf_hi(a1.z) + w2 * bf_hi(a2.z)) * bf_hi(z.z));
    w.w = pk((w0 * bf_lo(a0.w) + w1 * bf_lo(a1.w) + w2 * bf_lo(a2.w)) * bf_lo(z.w), (w0 * bf_hi(a0.w) + w1 * bf_hi(a1.w) + w2 * bf_hi(a2.w)) * bf_hi(z.w));
    *(u32x4*)(P_A2(p) + (size_t)(R >> 2) * 1536 + 1024 + (R & 3) * 128 + dq) = w;
  }
}

__global__ void __launch_bounds__(512) hybrid_fwd(Params p) {
  cg::grid_group grid = cg::this_grid();
  __shared__ __attribute__((aligned(1024))) unsigned char smem[151552 + 16];
  LAS unsigned char* lds = (LAS unsigned char*)smem;
  const int wid = __builtin_amdgcn_readfirstlane(threadIdx.x >> 6);
  volatile LAS unsigned* xst = (volatile LAS unsigned*)(lds + 151552);
  if (wid == 0 && lane_id() == 0) { xst[0] = 0u; xst[1] = 0u; }
  __syncthreads();
  const XcdBarrier xb = xcd_barrier_post(P_CNT(p), xst, wid == 0 && lane_id() == 0);
  phase0(p, lds, wid);
  if (p.ws == nullptr) grid.sync();
  xcd_barrier(xb, wid);
  { Epi<1> E; E.p = p; gemm_phase<1>(lds, 1024, 8, E, wid); }
  xcd_barrier(xb, wid);
  {
    if (wid < 2) {
      if (gridDim.x == 256) { const int xcd = blockIdx.x & 7, slot = blockIdx.x >> 3; gla_scan_item(p, lds + wid * 4096, (xcd + 8 * (slot >> 4)) * 32 + (slot & 15) * 2 + wid, lane_id()); }
      else for (int item = blockIdx.x * 2 + wid; item < 512; item += gridDim.x * 2) gla_scan_item(p, lds + wid * 4096, item, lane_id());
    }
    else {
      for (int idx = blockIdx.x * 6 + (wid - 2); idx < 5376; idx += gridDim.x * 6) conv_wave_tile(p, lds + 8192 + (wid - 2) * 8704, idx, lane_id());
      for (int c = blockIdx.x; c < 256; c += gridDim.x) rope_chunk(p, c, (wid - 2) * 64 + lane_id());
    }
  }
  xcd_barrier(xb, wid);
  for (int item = blockIdx.x * 8 + wid; item < 2048; item += gridDim.x * 8) gla_out_item(p, lds + wid * 16896, item, lane_id());
  xcd_barrier(xb, wid);
  { Epi<2> E; E.p = p; gemm_phase<2>(lds, 1024, 24, E, wid); }
  xcd_barrier(xb, wid);
  for (int idx = blockIdx.x * 8 + wid; idx < 6144; idx += gridDim.x * 8) attn_group_item<false>(p, lds + wid * 18944, idx & 2047, lane_id(), idx >> 11);
  xcd_barrier(xb, wid);
  attn_merge_pass(p, wid, lane_id());
  xcd_barrier(xb, wid);
  { Epi<3> E; E.p = p; gemm_phase<3>(lds, 1024, 8, E, wid); }
  asm volatile("s_waitcnt vmcnt(0)" ::: "memory"); __syncthreads();
  { Epi<4> E; E.p = p; gemm_phase<4>(lds, 1536, 4, E, wid); }
  xcd_barrier(xb, wid);
  { Epi<5> E; E.p = p; gemm_phase<5>(lds, 1024, 4, E, wid); }
}

extern "C" void kernel_launch(void* const* d_in, const int* in_sizes, int n_in, void* d_out, int out_size, void* d_ws, size_t ws_size, hipStream_t stream) {
  static int grid_blocks = 0;
  if (!grid_blocks) {
    int dev = 0, cus = 0, per_cu = 0;
    (void)hipGetDevice(&dev);
    (void)hipDeviceGetAttribute(&cus, hipDeviceAttributeMultiprocessorCount, dev);
    (void)hipOccupancyMaxActiveBlocksPerMultiprocessor(&per_cu, hybrid_fwd, 512, 0);
    if (per_cu < 1) per_cu = 1;
    grid_blocks = cus * (per_cu > 1 ? 1 : per_cu);
  }
  Params p{};
  p.x = (const float*)d_in[0]; p.pos = (const int*)d_in[1]; p.norm_gain = (const float*)d_in[2]; p.w_in = (const float*)d_in[3];
  p.w_a2 = (const float*)d_in[4]; p.b_a = (const float*)d_in[5]; p.gla_gain = (const float*)d_in[6]; p.qg = (const float*)d_in[7]; p.kg = (const float*)d_in[8];
  p.w_go = (const float*)d_in[9]; p.w_do = (const float*)d_in[10]; p.w_o = (const float*)d_in[11];
  p.ws = (unsigned char*)d_ws; p.out = (unsigned char*)d_out;
  (void)hipMemsetAsync((unsigned char*)d_ws + MB(43) + 786432, 0, 16384, stream);
  void* args[] = {&p};
  (void)hipLaunchCooperativeKernel((void*)hybrid_fwd, dim3(grid_blocks), dim3(512), args, 0, stream);
}
```

```cpp
#include <hip/hip_runtime.h>
#include <hip/hip_cooperative_groups.h>
namespace cg = cooperative_groups;

#define LAS __attribute__((address_space(3)))
#define DI __device__ __forceinline__
typedef unsigned short bf16_t;
typedef short bf16x8 __attribute__((ext_vector_type(8)));
typedef short s16x4 __attribute__((ext_vector_type(4)));
typedef float f32x2 __attribute__((ext_vector_type(2)));
typedef float f32x4 __attribute__((ext_vector_type(4)));
typedef float f32x16 __attribute__((ext_vector_type(16)));
typedef unsigned u32x4 __attribute__((ext_vector_type(4)));
typedef unsigned u32x2 __attribute__((ext_vector_type(2)));
typedef __bf16 bf16x2v __attribute__((ext_vector_type(2)));

struct Params {
  const float* x; const int* pos; const float* norm_gain; const float* w_in; const float* w_a2; const float* b_a;
  const float* gla_gain; const float* qg; const float* kg; const float* w_go; const float* w_do; const float* w_o;
  unsigned char* ws; unsigned char* out;
};

#define MB(v) ((size_t)(v) << 20)
#define VAT_LD 16448
#define VDT_LD 4160
#define P_HN(p)    ((bf16_t*)((p).ws + MB(0)))
#define P_Y(p)     ((bf16_t*)((p).ws + MB(0)))
#define P_WINTB(p) ((bf16_t*)((p).ws + MB(32)))
#define P_W2T(p)   ((bf16_t*)((p).ws + MB(38)))
#define P_WOT(p)   ((bf16_t*)((p).ws + MB(41)))
#define P_BL(p)    ((float*)((p).ws + MB(43)))
#define P_CNT(p)   ((unsigned*)((p).ws + MB(43) + 786432))
#define P_A2(p)    ((bf16_t*)((p).ws + MB(44)))
#define P_QD(p)    ((bf16_t*)((p).ws + MB(92)))
#define P_KD(p)    ((bf16_t*)((p).ws + MB(140)))
#define P_VDT(p)   ((bf16_t*)((p).ws + MB(188)))
#define P_ZD(p)    ((bf16_t*)((p).ws + MB(237)))
#define P_QT(p)    ((bf16_t*)((p).ws + MB(92)))
#define P_KT(p)    ((bf16_t*)((p).ws + MB(108)))
#define P_VAT(p)   ((bf16_t*)((p).ws + MB(124)))
#define P_SFRAG(p) ((bf16_t*)((p).ws + MB(188)))
#define P_BCUM(p)  ((float*)((p).out + MB(0)))
#define P_WINTG(p) ((bf16_t*)((p).out + MB(32)))
#define P_WINTD(p) ((bf16_t*)((p).out + MB(36)))
#define P_CS(p)    ((unsigned*)((p).out + MB(46)))
#define P_OG0(p)   ((bf16_t*)((p).out + MB(0)))
#define P_OG1(p)   ((bf16_t*)((p).out + MB(16)))
#define P_LSE0(p)  ((float*)((p).out + MB(32)))
#define P_LSE1(p)  ((float*)((p).out + MB(32) + 262144))
#define P_OG2(p)   ((bf16_t*)((p).out + MB(33)))
#define P_LSE2(p)  ((float*)((p).out + MB(32) + 524288))
#define P_GA(p)    ((bf16_t*)((p).out + MB(0)))
#define P_GD(p)    ((bf16_t*)((p).out + MB(32)))

DI unsigned pk(float a, float b) { f32x2 v = {a, b}; bf16x2v r = __builtin_convertvector(v, bf16x2v); return __builtin_bit_cast(unsigned, r); }
DI float h_lo(unsigned u) { return (float)__builtin_bit_cast(_Float16, (unsigned short)(u & 0xffffu)); }
DI float h_hi(unsigned u) { return (float)__builtin_bit_cast(_Float16, (unsigned short)(u >> 16)); }
DI float bf_lo(unsigned u) { return __uint_as_float(u << 16); }
DI float bf_hi(unsigned u) { return __uint_as_float(u & 0xffff0000u); }
DI float fast_exp(float x) { return __builtin_amdgcn_exp2f(x * 1.4426950408889634f); }
DI int lane_id() { return (int)__builtin_amdgcn_mbcnt_hi(~0u, __builtin_amdgcn_mbcnt_lo(~0u, 0u)); }
DI float wave_sum(float v) {
#pragma unroll
  for (int o = 32; o; o >>= 1) v += __shfl_xor(v, o);
  return v;
}
DI float sigmoidf_(float x) { return __builtin_amdgcn_rcpf(1.0f + fast_exp(-x)); }
DI float siluf_(float x) { return x * __builtin_amdgcn_rcpf(1.0f + fast_exp(-x)); }
#define MFMA32(a, b, c) __builtin_amdgcn_mfma_f32_32x32x16_bf16((a), (b), (c), 0, 0, 0)
DI int crow(int reg, int h) { return (reg & 3) + 8 * (reg >> 2) + 4 * h; }
DI bf16x8 cat4(s16x4 lo, s16x4 hi) { return __builtin_shufflevector(lo, hi, 0, 1, 2, 3, 4, 5, 6, 7); }
DI bf16x8 pack8(const f32x16& x, int s) {
  u32x4 w;
  w.x = pk(x[8 * s + 0], x[8 * s + 1]); w.y = pk(x[8 * s + 2], x[8 * s + 3]); w.z = pk(x[8 * s + 4], x[8 * s + 5]); w.w = pk(x[8 * s + 6], x[8 * s + 7]);
  return __builtin_bit_cast(bf16x8, w);
}

DI void grid_barrier(unsigned* cnt, unsigned target, int wid) {
  asm volatile("s_waitcnt vmcnt(0) lgkmcnt(0)" ::: "memory");
  __syncthreads();
  if (wid == 0 && lane_id() == 0) {
    __builtin_amdgcn_fence(__ATOMIC_RELEASE, "agent");
    asm volatile("s_waitcnt vmcnt(0)" ::: "memory");
    __hip_atomic_fetch_add(cnt, 1u, __ATOMIC_RELAXED, __HIP_MEMORY_SCOPE_AGENT);
    while (__hip_atomic_load(cnt, __ATOMIC_RELAXED, __HIP_MEMORY_SCOPE_AGENT) < target) __builtin_amdgcn_s_sleep(2);
    __builtin_amdgcn_fence(__ATOMIC_ACQUIRE, "agent");
    asm volatile("s_waitcnt vmcnt(0)" ::: "memory");
  }
  __syncthreads();
}

#define XB_TMO      128
#define XB_XCNT(j)  (256  + 64 * (j))
#define XB_XSUB(j)  (1280 + 64 * (j))
#define XB_XGEN(j)  (2304 + 64 * (j))
#define XB_TOP      3328
#define XB_TOPGEN   3392
#define XB_SPIN_CAP (1u << 18)
DI unsigned xb_ld(unsigned* p)              { return __hip_atomic_load(p, __ATOMIC_RELAXED, __HIP_MEMORY_SCOPE_AGENT); }
DI unsigned xb_add(unsigned* p, unsigned v) { return __hip_atomic_fetch_add(p, v, __ATOMIC_RELAXED, __HIP_MEMORY_SCOPE_AGENT); }
DI unsigned xb_xcc_id() { return (unsigned)__builtin_amdgcn_s_getreg((3 << 11) | 20) & 0xFu; }
#define XB_SPIN(cond, bar) do { unsigned _sp = 0; while (cond) { __builtin_amdgcn_s_sleep(1); \
    if ((++_sp & 255u) == 0u) { if (xb_ld(&(bar)[XB_TMO])) break; if (_sp > XB_SPIN_CAP) { atomicAdd(&(bar)[XB_TMO], 1u); break; } } } } while (0)
struct XcdBarrier { unsigned* bar; unsigned x; volatile LAS unsigned* st; };
DI XcdBarrier xcd_barrier_post(unsigned* bar, volatile LAS unsigned* st, const bool leader) {
  XcdBarrier b; b.bar = bar; b.x = xb_xcc_id(); b.st = st;
  if (leader) (void)xb_add(&bar[XB_XCNT(b.x)], 1u);
  return b;
}
DI void xcd_barrier_complete(unsigned* bar, unsigned x, unsigned& nloc, unsigned& nx) {
  const unsigned G = gridDim.x;
  unsigned sum, cnt, mine, sp = 0u;
  for (;;) {
    sum = 0u; cnt = 0u; mine = 0u;
#pragma unroll
    for (unsigned j = 0; j < 16; ++j) { const unsigned c = xb_ld(&bar[XB_XCNT(j)]); sum += c; cnt += (c > 0u) ? 1u : 0u; mine = (j == x) ? c : mine; }
    if (sum == G) break;
    __builtin_amdgcn_s_sleep(1);
    if ((++sp & 255u) == 0u) { if (xb_ld(&bar[XB_TMO])) break; if (sp > XB_SPIN_CAP) { atomicAdd(&bar[XB_TMO], 1u); break; } }
  }
  nloc = mine > 0u ? mine : 1u; nx = cnt > 0u ? cnt : 1u;
}
DI void xcd_barrier(const XcdBarrier& b, const int wid) {
  asm volatile("s_waitcnt vmcnt(0) lgkmcnt(0)" ::: "memory");
  __syncthreads();
  if (wid == 0 && lane_id() == 0) {
    unsigned* bar = b.bar;
    __builtin_amdgcn_s_waitcnt(0);
    unsigned nloc = b.st[0], nx = b.st[1];
    if (nloc == 0u) { xcd_barrier_complete(bar, b.x, nloc, nx); b.st[0] = nloc; b.st[1] = nx; }
    const unsigned old = xb_add(&bar[XB_XSUB(b.x)], 1u);
    const unsigned gen = old / nloc;
    if (old + 1u == (gen + 1u) * nloc) {
      __builtin_amdgcn_fence(__ATOMIC_RELEASE, "agent");
      asm volatile("s_waitcnt vmcnt(0)" ::: "memory");
      const unsigned og = xb_add(&bar[XB_TOP], 1u);
      const unsigned tg = og / nx;
      if (og + 1u == (tg + 1u) * nx) xb_add(&bar[XB_TOPGEN], 1u);
      else XB_SPIN(xb_ld(&bar[XB_TOPGEN]) == tg, bar);
      __builtin_amdgcn_fence(__ATOMIC_ACQUIRE, "agent");
      xb_add(&bar[XB_XGEN(b.x)], 1u);
      asm volatile("s_waitcnt vmcnt(0)" ::: "memory");
    } else {
      XB_SPIN(xb_ld(&bar[XB_XGEN(b.x)]) == gen, bar);
      __builtin_amdgcn_fence(__ATOMIC_ACQUIRE, "agent");
      asm volatile("s_waitcnt vmcnt(0)" ::: "memory");
    }
  }
  __syncthreads();
}

DI void conv_tile(const Params& p, LAS unsigned char* ldsb, int idx, const int wid) {
  int tid = wid * 64 + lane_id(); asm volatile("" : "+v"(tid));
  const float* src; int ld_src, sc; bf16_t* dst; int ld_dst, drow, dk0 = 0, rg, kb;
  if (idx < 512) { rg = idx >> 3; kb = idx & 7; const int n = rg * 32; src = p.w_in; ld_src = 10256; sc = n; dst = P_WINTG(p); ld_dst = 1024; drow = n; }
  else if (idx < 1792) { const int i = idx - 512; rg = i >> 3; kb = i & 7; const int n = rg * 32; src = p.w_in; ld_src = 10256; dst = P_WINTD(p); ld_dst = 1024; drow = n;
    if (n < 3072) { const int seg = n >= 1536; const int nn = n - seg * 1536; const int tq = nn >> 8, pp = nn & 255; const int wc = (pp >> 5) & 3, bj = pp >> 7;
      const int f = 128 * (wc >> 1) + 64 * bj + 32 * (wc & 1); sc = (seg ? 4624 : 3088) + 256 * tq + f; }
    else if (n < 4608) sc = 6160 + (n - 3072); else sc = 7696 + (n - 4608); }
  else if (idx < 2560) { const int i = idx - 1792; rg = i >> 3; kb = i & 7; const int n = rg * 32; src = p.w_in; ld_src = 10256; dst = P_WINTB(p); ld_dst = 1024; drow = n;
    sc = n < 1024 ? 2048 + n : (n < 2048 ? 8208 + (n - 1024) : 9232 + (n - 2048)); }
  else if (idx < 2816) { const int i = idx - 2560; rg = i >> 3; kb = i & 7; src = p.w_go; ld_src = 1024; sc = rg * 32; dst = P_W2T(p); ld_dst = 1536; drow = rg * 32; }
  else if (idx < 2944) { const int i = idx - 2816; rg = i >> 2; kb = i & 3; src = p.w_do; ld_src = 1024; sc = rg * 32; dst = P_W2T(p); ld_dst = 1536; drow = rg * 32; dk0 = 1024; }
  else { const int i = idx - 2944; rg = i >> 3; kb = i & 7; src = p.w_o; ld_src = 1024; sc = rg * 32; dst = P_WOT(p); ld_dst = 1024; drow = rg * 32; }
  const int k0 = kb * 128;
  LAS float* tl = (LAS float*)ldsb;
#pragma unroll
  for (int e = 0; e < 2; ++e) {
    const int kk = (tid >> 3) + 64 * e, c4 = 4 * (tid & 7);
    const f32x4 v = *(const f32x4*)(src + (size_t)(k0 + kk) * ld_src + sc + c4);
    tl[kk * 33 + c4 + 0] = v[0]; tl[kk * 33 + c4 + 1] = v[1]; tl[kk * 33 + c4 + 2] = v[2]; tl[kk * 33 + c4 + 3] = v[3];
  }
  __syncthreads();
  {
    const int nn = tid >> 4, kp = (tid & 15) * 8;
    float v[8];
#pragma unroll
    for (int e = 0; e < 8; ++e) v[e] = tl[(kp + e) * 33 + nn];
    u32x4 w; w.x = pk(v[0], v[1]); w.y = pk(v[2], v[3]); w.z = pk(v[4], v[5]); w.w = pk(v[6], v[7]);
    *(u32x4*)(dst + (size_t)(drow + nn) * ld_dst + dk0 + k0 + kp) = w;
  }
  __syncthreads();
}

DI void conv_wave_tile(const Params& p, LAS unsigned char* ldsb, int idx, int lane) {
  asm volatile("" : "+v"(lane));
  const float* src; int ld_src, sc; bf16_t* dst; int ld_dst, drow, dk0 = 0, rg, kb;
  if (idx < 2560) { rg = idx >> 4; kb = idx & 15; const int n = rg * 32; src = p.w_in; ld_src = 10256; dst = P_WINTD(p); ld_dst = 1024; drow = n;
    if (n < 3072) { const int seg = n >= 1536; const int nn = n - seg * 1536; const int tq = nn >> 8, pp = nn & 255; const int wc = (pp >> 5) & 3, bj = pp >> 7;
      const int f = 128 * (wc >> 1) + 64 * bj + 32 * (wc & 1); sc = (seg ? 4624 : 3088) + 256 * tq + f; }
    else if (n < 4608) sc = 6160 + (n - 3072); else sc = 7696 + (n - 4608); }
  else if (idx < 4096) { const int i = idx - 2560; rg = i >> 4; kb = i & 15; const int n = rg * 32; src = p.w_in; ld_src = 10256; dst = P_WINTB(p); ld_dst = 1024; drow = n;
    sc = n < 1024 ? 2048 + n : (n < 2048 ? 8208 + (n - 1024) : 9232 + (n - 2048)); }
  else if (idx < 4608) { const int i = idx - 4096; rg = i >> 4; kb = i & 15; src = p.w_go; ld_src = 1024; sc = rg * 32; dst = P_W2T(p); ld_dst = 1536; drow = rg * 32; }
  else if (idx < 4864) { const int i = idx - 4608; rg = i >> 3; kb = i & 7; src = p.w_do; ld_src = 1024; sc = rg * 32; dst = P_W2T(p); ld_dst = 1536; drow = rg * 32; dk0 = 1024; }
  else { const int i = idx - 4864; rg = i >> 4; kb = i & 15; src = p.w_o; ld_src = 1024; sc = rg * 32; dst = P_WOT(p); ld_dst = 1024; drow = rg * 32; }
  const int k0 = kb * 64;
  LAS float* tl = (LAS float*)ldsb;
  f32x4 v[8];
#pragma unroll
  for (int e = 0; e < 8; ++e) v[e] = *(const f32x4*)(src + (size_t)(k0 + (lane >> 3) + 8 * e) * ld_src + sc + 4 * (lane & 7));
#pragma unroll
  for (int e = 0; e < 8; ++e) { const int kk = (lane >> 3) + 8 * e, c4 = 4 * (lane & 7); tl[kk * 33 + c4 + 0] = v[e][0]; tl[kk * 33 + c4 + 1] = v[e][1]; tl[kk * 33 + c4 + 2] = v[e][2]; tl[kk * 33 + c4 + 3] = v[e][3]; }
  asm volatile("s_waitcnt lgkmcnt(0)" ::: "memory");
  const int nn = lane >> 1, kh = (lane & 1) * 32;
  bf16_t* drp = dst + (size_t)(drow + nn) * ld_dst + dk0 + k0 + kh;
#pragma unroll
  for (int q = 0; q < 4; ++q) {
    float t[8];
#pragma unroll
    for (int e = 0; e < 8; ++e) t[e] = tl[(kh + 8 * q + e) * 33 + nn];
    u32x4 w; w.x = pk(t[0], t[1]); w.y = pk(t[2], t[3]); w.z = pk(t[4], t[5]); w.w = pk(t[6], t[7]);
    *(u32x4*)(drp + 8 * q) = w;
  }
  asm volatile("s_waitcnt lgkmcnt(0)" ::: "memory");
}

DI void rope_chunk(const Params& p, const int c, const int t384) {
#pragma unroll 1
  for (int idx = t384; idx < 4096; idx += 384) {
    const int t = idx >> 6, i = idx & 63; const size_t token = (size_t)c * 64 + t;
    double inv = 1.0;
    if (i & 1) inv *= 0.8659643233600653; if (i & 2) inv *= 0.7498942093324558; if (i & 4) inv *= 0.5623413251903491;
    if (i & 8) inv *= 0.31622776601683794; if (i & 16) inv *= 0.09999999999999999; if (i & 32) inv *= 0.009999999999999998;
    const float angf = (float)p.pos[token] * (float)inv;
    const double a = (double)angf; const double q = rint(a * 0.6366197723675814);
    double y = fma(-q, 1.5707963267948966, a); y = fma(-q, 6.123233995736766e-17, y);
    const double y2 = y * y;
    double sp = 1.0 / 6227020800.0; sp = sp * y2 - 1.0 / 39916800.0; sp = sp * y2 + 1.0 / 362880.0; sp = sp * y2 - 1.0 / 5040.0; sp = sp * y2 + 1.0 / 120.0; sp = sp * y2 - 1.0 / 6.0; sp = sp * y2 * y + y;
    double cp = -1.0 / 87178291200.0; cp = cp * y2 + 1.0 / 479001600.0; cp = cp * y2 - 1.0 / 3628800.0; cp = cp * y2 + 1.0 / 40320.0; cp = cp * y2 - 1.0 / 720.0; cp = cp * y2 + 1.0 / 24.0; cp = cp * y2 - 0.5; cp = cp * y2 + 1.0;
    const int iq = ((int)q) & 3;
    const double sv = (iq == 0) ? sp : (iq == 1) ? cp : (iq == 2) ? -sp : -cp;
    const double cv = (iq == 0) ? cp : (iq == 1) ? -sp : (iq == 2) ? -cp : sp;
    const _Float16 hc = (_Float16)(float)cv, hsn = (_Float16)(float)sv;
    P_CS(p)[token * 64 + i] = (unsigned)__builtin_bit_cast(unsigned short, hc) | ((unsigned)__builtin_bit_cast(unsigned short, hsn) << 16);
  }
}

DI void phase0(const Params& p, LAS unsigned char* lds, const int wid) {
  int lane = lane_id(); asm volatile("" : "+v"(lane));
  const int tid = wid * 64 + lane;
  LAS bf16_t* hs = (LAS bf16_t*)lds;
  LAS bf16_t* w16s = (LAS bf16_t*)(lds + 66048);
  LAS float* alr = (LAS float*)(lds + 99072);
  LAS unsigned char* tl = lds + 103168;
  for (int c = blockIdx.x; c < 256; c += gridDim.x) {
    f32x4 vv[2][4][4];
#pragma unroll
    for (int ps = 0; ps < 2; ++ps)
#pragma unroll
      for (int rr = 0; rr < 4; ++rr)
#pragma unroll
        for (int j = 0; j < 4; ++j) vv[ps][rr][j] = *(const f32x4*)(p.x + ((size_t)c * 64 + ps * 32 + wid * 4 + rr) * 1024 + 256 * j + 4 * lane);
    if (c == (int)blockIdx.x)
      for (int idx = tid; idx < 16384; idx += 512) { const int k = idx >> 4, cc = idx & 15; const float wv = p.w_in[(size_t)k * 10256 + 3072 + cc]; w16s[cc * 1032 + k] = (bf16_t)(pk(wv, 0.f) & 0xffffu); }
#pragma unroll
    for (int ps = 0; ps < 2; ++ps) {
      f32x4 (&v)[4][4] = vv[ps];
#pragma unroll
      for (int rr = 0; rr < 4; ++rr) {
        const int lrow = wid * 4 + rr; const size_t token = (size_t)c * 64 + ps * 32 + lrow;
        float ss = 0.f;
#pragma unroll
        for (int j = 0; j < 4; ++j) ss += v[rr][j][0] * v[rr][j][0] + v[rr][j][1] * v[rr][j][1] + v[rr][j][2] * v[rr][j][2] + v[rr][j][3] * v[rr][j][3];
        ss = wave_sum(ss);
        const float rstd = __builtin_amdgcn_rsqf(ss * (1.0f / 1024.0f) + 1e-6f);
#pragma unroll
        for (int j = 0; j < 4; ++j) {
          const f32x4 g = *(const f32x4*)(p.norm_gain + 256 * j + 4 * lane);
          u32x2 w; w.x = pk(v[rr][j][0] * rstd * g[0], v[rr][j][1] * rstd * g[1]); w.y = pk(v[rr][j][2] * rstd * g[2], v[rr][j][3] * rstd * g[3]);
          *(u32x2*)(P_HN(p) + token * 1024 + 256 * j + 4 * lane) = w;
          *(LAS u32x2*)(hs + lrow * 1032 + 256 * j + 4 * lane) = w;
        }
      }
      __syncthreads();
      if (wid < 2) {
        f32x4 acc = {0.f, 0.f, 0.f, 0.f};
        const int m = lane & 15, kq = lane >> 4;
#pragma unroll 4
        for (int s = 0; s < 32; ++s) {
          const bf16x8 a = *(const LAS bf16x8*)(hs + (16 * wid + m) * 1032 + 32 * s + 8 * kq);
          const bf16x8 b = *(const LAS bf16x8*)(w16s + m * 1032 + 32 * s + 8 * kq);
          acc = __builtin_amdgcn_mfma_f32_16x16x32_bf16(a, b, acc, 0, 0, 0);
        }
#pragma unroll
        for (int i = 0; i < 4; ++i) alr[(32 * ps + 16 * wid + 4 * kq + i) * 16 + m] = acc[i];
      }
      __syncthreads();
    }
    {
      float wa[16];
#pragma unroll
      for (int r = 0; r < 16; ++r) wa[r] = p.w_a2[r * 512 + tid];
      const float bias = p.b_a[tid];
      float run = 0.f; float* bc = P_BCUM(p) + (size_t)c * 64 * 512 + tid;
#pragma unroll 2
      for (int t = 0; t < 64; ++t) {
        float z = bias;
#pragma unroll
        for (int r4 = 0; r4 < 4; ++r4) { const f32x4 av = *(const LAS f32x4*)(alr + t * 16 + 4 * r4); z += av[0] * wa[4 * r4] + av[1] * wa[4 * r4 + 1] + av[2] * wa[4 * r4 + 2] + av[3] * wa[4 * r4 + 3]; }
        const float ls = fminf(z, 0.f) - 0.6931471805599453f * __builtin_amdgcn_logf(1.0f + fast_exp(-fabsf(z)));
        run += ls * 0.0625f;
        bc[(size_t)t * 512] = run;
      }
      P_BL(p)[c * 512 + tid] = run;
    }
    __syncthreads();
  }
  for (int idx = blockIdx.x; idx < 512; idx += gridDim.x) conv_tile(p, tl, idx, wid);
}

constexpr int BM = 256, BK = 64, HALF = 128, HTB = HALF * BK * 2, NXCD = 8, WGM = 8;
DI int lds_byte(int r, int c) { const int st = (r >> 4) * 2 + (c >> 5), rr = r & 15, cc = c & 31, ob = rr * 64 + cc * 2; return st * 1024 + (ob ^ (((ob >> 9) & 1) << 5)); }
DI void stage_rc(int b, int& R, int& C) { const int st = b / 1024, sb = b % 1024, swz = sb ^ (((sb >> 9) & 1) << 5); R = (st >> 1) * 16 + swz / 64; C = (st & 1) * 32 + (swz % 64) / 2; }
DI int perm32(int rho) { const int n = rho >> 4, i = rho & 15; return 8 * (i >> 2) + 4 * n + (i & 3); }
DI int tokmap(int v, int rho) { return v == 0 ? rho : (v == 1 ? (((rho & 63) << 2) + (rho >> 6)) : (((rho & 15) << 4) + (rho >> 4))); }
struct Unit { int pm, pn; };
struct StaticOrder {
  int nM, nN, nwg, G, c;
  DI void init(int nM_, int nN_, int G_, int c_) { nM = nM_; nN = nN_; nwg = nM * nN; G = G_; c = c_; }
  DI bool next(int i, Unit& u) const {
    const long L = (long)i * G + c; if (L >= nwg) return false;
    int wgid = (int)L; { const int q = nwg / NXCD, r = nwg % NXCD, xcd = wgid % NXCD, off = wgid / NXCD; wgid = (xcd < r ? xcd * (q + 1) : r * (q + 1) + (xcd - r) * q) + off; }
    const int nig = WGM * nN, gid = wgid / nig, fm = gid * WGM, gsz = (nM - fm) < WGM ? (nM - fm) : WGM;
    u.pm = fm + ((wgid % nig) % gsz); u.pn = (wgid % nig) / gsz; return true;
  }
};

template <int PH> struct Epi {
  static constexpr bool VARIANTS = (PH == 2), HAS_MID = (PH == 4);
  Params p;
  DI void setup(const Unit& u, int K, const char*& row, const char*& col, int& var) const {
    const size_t tstep = (size_t)256 * K * 2; var = 0;
    if (PH == 1) { const char* w = (const char*)P_WINTG(p) + u.pn * tstep; const char* h = (const char*)P_HN(p) + u.pm * tstep; if (u.pn < 4) { row = h; col = w; } else { row = w; col = h; } }
    else if (PH == 2) { const char* w = (const char*)P_WINTD(p) + u.pn * tstep; const char* h = (const char*)P_HN(p) + u.pm * tstep;
      if (u.pn >= 12 && u.pn < 18) { row = w; col = h; var = (u.pn - 12) >> 1; } else if (u.pn < 20) { row = h; col = w; } else { row = h; col = (const char*)P_WINTB(p) + (u.pn - 20) * tstep; } }
    else if (PH == 3) { row = (const char*)P_HN(p) + u.pm * tstep; col = (const char*)P_WINTB(p) + (4 + u.pn) * tstep; }
    else if (PH == 4) { row = (const char*)P_A2(p) + u.pm * tstep; col = (const char*)P_W2T(p) + u.pn * tstep; }
    else { row = (const char*)P_Y(p) + u.pm * tstep; col = (const char*)P_WOT(p) + u.pn * tstep; }
  }
  DI void mid(f32x4 (&acc)[2][2][4][2], const Unit& u, int wr, int wc, int fr, int fq) const {
    asm volatile("" : "+v"(fr), "+v"(fq));
#pragma unroll
    for (int ai = 0; ai < 2; ++ai)
#pragma unroll
      for (int m = 0; m < 4; ++m)
#pragma unroll
        for (int bj = 0; bj < 2; ++bj) {
          const size_t off = (size_t)(u.pm * 256 + ai * 128 + wr * 64 + m * 16 + fr) * 1024 + u.pn * 256 + bj * 128 + wc * 32 + fq * 8;
          const u32x4 a = *(const u32x4*)(P_GA(p) + off), d = *(const u32x4*)(P_GD(p) + off);
          acc[ai][bj][m][0][0] *= bf_lo(a.x) * __builtin_amdgcn_rcpf(bf_lo(d.x)); acc[ai][bj][m][0][1] *= bf_hi(a.x) * __builtin_amdgcn_rcpf(bf_hi(d.x));
          acc[ai][bj][m][0][2] *= bf_lo(a.y) * __builtin_amdgcn_rcpf(bf_lo(d.y)); acc[ai][bj][m][0][3] *= bf_hi(a.y) * __builtin_amdgcn_rcpf(bf_hi(d.y));
          acc[ai][bj][m][1][0] *= bf_lo(a.z) * __builtin_amdgcn_rcpf(bf_lo(d.z)); acc[ai][bj][m][1][1] *= bf_hi(a.z) * __builtin_amdgcn_rcpf(bf_hi(d.z));
          acc[ai][bj][m][1][2] *= bf_lo(a.w) * __builtin_amdgcn_rcpf(bf_lo(d.w)); acc[ai][bj][m][1][3] *= bf_hi(a.w) * __builtin_amdgcn_rcpf(bf_hi(d.w));
        }
  }
  DI void operator()(f32x4 (&acc)[2][2][4][2], const Unit& u, int wr, int wc, int fr, int fq, LAS unsigned char* lds) const {
    asm volatile("" : "+v"(fr), "+v"(fq));
    const bool qkd = (PH == 2) && (u.pn < 12);
    if (PH == 2 && qkd) {
      LAS float* Xs = (LAS float*)(lds + 131072);
      const bool isk = u.pn >= 6; const int tq = isk ? u.pn - 6 : u.pn; const int head = 2 * tq + (wc >> 1), lg = 2 * (tq >> 1);
      u32x4 csr[4][2];
#pragma unroll
      for (int m = 0; m < 4; ++m) {
        const int token = u.pm * 256 + wr * 64 + m * 16 + fr;
        const unsigned* cp = P_CS(p) + (size_t)token * 64 + 32 * (wc & 1) + 8 * fq;
        csr[m][0] = *(const u32x4*)cp; csr[m][1] = *(const u32x4*)(cp + 4);
      }
      float ssq[2][4];
#pragma unroll
      for (int ai = 0; ai < 2; ++ai)
#pragma unroll
        for (int m = 0; m < 4; ++m) {
          float s = 0.f;
#pragma unroll
          for (int bj = 0; bj < 2; ++bj)
#pragma unroll
            for (int n = 0; n < 2; ++n) { const f32x4 v = acc[ai][bj][m][n]; s += v[0] * v[0] + v[1] * v[1] + v[2] * v[2] + v[3] * v[3]; }
          s += __shfl_xor(s, 16); s += __shfl_xor(s, 32); ssq[ai][m] = s;
          if (fq == 0) Xs[(wr * 128 + (ai * 4 + m) * 16 + fr) * 4 + wc] = s;
        }
      asm volatile("s_waitcnt lgkmcnt(0)" ::: "memory"); __builtin_amdgcn_s_barrier(); asm volatile("" ::: "memory");
      const float* gp = (isk ? p.kg : p.qg) + 32 * (wc & 1) + 8 * fq;
      const f32x4 g00 = *(const f32x4*)(gp), g01 = *(const f32x4*)(gp + 4), g10 = *(const f32x4*)(gp + 64), g11 = *(const f32x4*)(gp + 68);
      bf16_t* dstb = isk ? P_KD(p) : P_QD(p);
#pragma unroll
      for (int ai = 0; ai < 2; ++ai) {
        if (ai == 1) {
#pragma unroll
          for (int m = 0; m < 4; ++m) {
            const int token = u.pm * 256 + 128 + wr * 64 + m * 16 + fr;
            const unsigned* cp = P_CS(p) + (size_t)token * 64 + 32 * (wc & 1) + 8 * fq;
            csr[m][0] = *(const u32x4*)cp; csr[m][1] = *(const u32x4*)(cp + 4);
          }
        }
#pragma unroll
        for (int m = 0; m < 4; ++m) {
          const float tot = ssq[ai][m] + Xs[(wr * 128 + (ai * 4 + m) * 16 + fr) * 4 + (wc ^ 1)];
          const float rstd = __builtin_amdgcn_rsqf(tot * (1.0f / 128.0f) + 1e-6f);
          const int token = u.pm * 256 + ai * 128 + wr * 64 + m * 16 + fr; const int b = token >> 12, s = token & 4095;
          const int dil = 1 << lg, r = s & (dil - 1), uu = s >> lg, L = 4096 >> lg;
          const u32x4 ca = csr[m][0], cb = csr[m][1];
          const f32x4 c0 = {h_lo(ca.x), h_lo(ca.y), h_lo(ca.z), h_lo(ca.w)}, s0 = {h_hi(ca.x), h_hi(ca.y), h_hi(ca.z), h_hi(ca.w)};
          const f32x4 c1 = {h_lo(cb.x), h_lo(cb.y), h_lo(cb.z), h_lo(cb.w)}, s1 = {h_hi(cb.x), h_hi(cb.y), h_hi(cb.z), h_hi(cb.w)};
          const f32x4 x1a = acc[ai][0][m][0] * rstd * g00, x1b = acc[ai][0][m][1] * rstd * g01, x2a = acc[ai][1][m][0] * rstd * g10, x2b = acc[ai][1][m][1] * rstd * g11;
          const f32x4 o1a = x1a * c0 - x2a * s0, o1b = x1b * c1 - x2b * s1, o2a = x2a * c0 + x1a * s0, o2b = x2b * c1 + x1b * s1;
          bf16_t* drow = dstb + ((size_t)(b * 12 + head) * 4096 + r * L + uu) * 128 + 32 * (wc & 1) + 8 * fq;
          u32x4 w; w.x = pk(o1a[0], o1a[1]); w.y = pk(o1a[2], o1a[3]); w.z = pk(o1b[0], o1b[1]); w.w = pk(o1b[2], o1b[3]); *(u32x4*)drow = w;
          w.x = pk(o2a[0], o2a[1]); w.y = pk(o2a[2], o2a[3]); w.z = pk(o2b[0], o2b[1]); w.w = pk(o2b[2], o2b[3]); *(u32x4*)(drow + 64) = w;
        }
      }
      return;
    }
    constexpr bool SIDE_F = (PH == 1 || PH == 5), SIDE_U = (PH == 2 || PH == 4);
#pragma unroll
    for (int ai = 0; ai < 2; ++ai) {
      f32x4 sf0[SIDE_F ? 4 : 1][2], sf1[SIDE_F ? 4 : 1][2]; u32x4 su[SIDE_U ? 4 : 1][2];
#pragma unroll
      for (int m = 0; m < 4; ++m)
#pragma unroll
        for (int bj = 0; bj < 2; ++bj) {
          const int row_l = ai * 128 + wr * 64 + m * 16 + fr, col_l = bj * 128 + wc * 32 + fq * 8;
          if (PH == 1 && u.pn < 4) { const float* bp = P_BCUM(p) + ((size_t)u.pm * 256 + row_l) * 512 + (u.pn & 1) * 256 + col_l; sf0[SIDE_F ? m : 0][bj] = *(const f32x4*)bp; sf1[SIDE_F ? m : 0][bj] = *(const f32x4*)(bp + 4); }
          if (PH == 5) { const float* xp = p.x + ((size_t)u.pm * 256 + row_l) * 1024 + u.pn * 256 + col_l; sf0[SIDE_F ? m : 0][bj] = *(const f32x4*)xp; sf1[SIDE_F ? m : 0][bj] = *(const f32x4*)(xp + 4); }
          if (PH == 2 && u.pn >= 20) su[SIDE_U ? m : 0][bj] = *(const u32x4*)(P_A2(p) + ((size_t)u.pm * 256 + row_l) * 1536 + (u.pn - 20) * 256 + col_l);
          if (PH == 4) su[SIDE_U ? m : 0][bj] = *(const u32x4*)(P_GD(p) + ((size_t)u.pm * 256 + row_l) * 1024 + u.pn * 256 + col_l);
        }
#pragma unroll
      for (int m = 0; m < 4; ++m)
#pragma unroll
        for (int bj = 0; bj < 2; ++bj) {
          const int row_l = ai * 128 + wr * 64 + m * 16 + fr, col_l = bj * 128 + wc * 32 + fq * 8;
          f32x4 v0 = acc[ai][bj][m][0], v1 = acc[ai][bj][m][1];
          if (PH == 1) {
            if (u.pn < 4) {
              const size_t token = (size_t)u.pm * 256 + row_l; const int fc = (u.pn & 1) * 256 + col_l;
              const f32x4 b0 = sf0[SIDE_F ? m : 0][bj], b1 = sf1[SIDE_F ? m : 0][bj];
              const bool isq = u.pn < 2; const float sc = isq ? 0.08838834764831845f : 1.0f, sg = isq ? 1.0f : -1.0f;
#pragma unroll
              for (int j = 0; j < 4; ++j) { v0[j] *= sc * fast_exp(sg * b0[j]); v1[j] *= sc * fast_exp(sg * b1[j]); }
              u32x4 w; w.x = pk(v0[0], v0[1]); w.y = pk(v0[2], v0[3]); w.z = pk(v1[0], v1[1]); w.w = pk(v1[2], v1[3]);
              *(u32x4*)((isq ? P_QT(p) : P_KT(p)) + token * 512 + fc) = w;
            } else {
              const int f = (u.pn - 4) * 256 + row_l; const size_t token = (size_t)u.pm * 256 + col_l;
              u32x4 w; w.x = pk(v0[0], v0[1]); w.y = pk(v0[2], v0[3]); w.z = pk(v1[0], v1[1]); w.w = pk(v1[2], v1[3]);
              *(u32x4*)(P_VAT(p) + (size_t)f * VAT_LD + token) = w;
            }
          } else if (PH == 2) {
            if (u.pn < 18) {
              const int tv = u.pn - 12, f = tv * 256 + row_l, head = f >> 7, d = f & 127, var = tv >> 1, lg = 2 * var;
              const int token = u.pm * 256 + tokmap(var, col_l); const int b = token >> 12, s = token & 4095;
              const int dil = 1 << lg, r = s & (dil - 1), uu = s >> lg, L = 4096 >> lg;
              u32x4 w; w.x = pk(v0[0], v0[1]); w.y = pk(v0[2], v0[3]); w.z = pk(v1[0], v1[1]); w.w = pk(v1[2], v1[3]);
              *(u32x4*)(P_VDT(p) + ((size_t)(b * 12 + head) * 128 + d) * VDT_LD + r * L + uu) = w;
            } else if (u.pn < 20) {
              const size_t token = (size_t)u.pm * 256 + row_l; const int fc = (u.pn - 18) * 256 + col_l;
              u32x4 w; w.x = pk(siluf_(v0[0]), siluf_(v0[1])); w.y = pk(siluf_(v0[2]), siluf_(v0[3])); w.z = pk(siluf_(v1[0]), siluf_(v1[1])); w.w = pk(siluf_(v1[2]), siluf_(v1[3]));
              *(u32x4*)(P_ZD(p) + token * 512 + fc) = w;
            } else {
              const size_t token = (size_t)u.pm * 256 + row_l;
              bf16_t* ap = P_A2(p) + token * 1536 + (u.pn - 20) * 256 + col_l; const u32x4 a = su[SIDE_U ? m : 0][bj];
              u32x4 w; w.x = pk(bf_lo(a.x) * siluf_(v0[0]), bf_hi(a.x) * siluf_(v0[1])); w.y = pk(bf_lo(a.y) * siluf_(v0[2]), bf_hi(a.y) * siluf_(v0[3]));
              w.z = pk(bf_lo(a.z) * siluf_(v1[0]), bf_hi(a.z) * siluf_(v1[1])); w.w = pk(bf_lo(a.w) * siluf_(v1[2]), bf_hi(a.w) * siluf_(v1[3]));
              *(u32x4*)ap = w;
            }
          } else if (PH == 3) {
            const size_t token = (size_t)u.pm * 256 + row_l;
            bf16_t* gp = (u.pn < 4 ? P_GA(p) : P_GD(p)) + token * 1024 + (u.pn & 3) * 256 + col_l;
            u32x4 w; w.x = pk(sigmoidf_(v0[0]), sigmoidf_(v0[1])); w.y = pk(sigmoidf_(v0[2]), sigmoidf_(v0[3])); w.z = pk(sigmoidf_(v1[0]), sigmoidf_(v1[1])); w.w = pk(sigmoidf_(v1[2]), sigmoidf_(v1[3]));
            *(u32x4*)gp = w;
          } else if (PH == 4) {
            const size_t off = ((size_t)u.pm * 256 + row_l) * 1024 + u.pn * 256 + col_l; const u32x4 d = su[SIDE_U ? m : 0][bj];
            u32x4 w; w.x = pk(v0[0] * bf_lo(d.x), v0[1] * bf_hi(d.x)); w.y = pk(v0[2] * bf_lo(d.y), v0[3] * bf_hi(d.y)); w.z = pk(v1[0] * bf_lo(d.z), v1[1] * bf_hi(d.z)); w.w = pk(v1[2] * bf_lo(d.w), v1[3] * bf_hi(d.w));
            *(u32x4*)(P_Y(p) + off) = w;
          } else {
            const size_t off = ((size_t)u.pm * 256 + row_l) * 1024 + u.pn * 256 + col_l;
            const f32x4 x0 = sf0[SIDE_F ? m : 0][bj], x1 = sf1[SIDE_F ? m : 0][bj];
            *(f32x4*)((float*)p.out + off) = x0 + v0; *(f32x4*)((float*)p.out + off + 4) = x1 + v1;
          }
        }
    }
  }
};

template <int PH>
DI void gemm_phase(LAS unsigned char* lds, const int K, const int nN, const Epi<PH>& E, const int wid) {
  int lane = lane_id(); asm volatile("" : "+v"(lane));
  const int tid = wid * 64 + lane, wr = wid >> 2, wc = wid & 3, fr = lane & 15, fq = lane >> 4;
  const int nt = K / BK;
  constexpr int NV = Epi<PH>::VARIANTS ? 3 : 1;
  unsigned voffA[2], voffB[NV][2];
#pragma unroll
  for (int i = 0; i < 2; ++i) { int R, C; stage_rc(tid * 16 + i * 8192, R, C); const int Rb = (R & ~31) + perm32(R & 31);
    voffA[i] = (unsigned)(R * K + C) * 2u;
#pragma unroll
    for (int v = 0; v < NV; ++v) voffB[v][i] = (unsigned)(tokmap(v, Rb) * K + C) * 2u; }
  const size_t kstep = (size_t)(BK * 2);
  const size_t hstepA = (size_t)HALF * K * 2;
  const unsigned ldsw = (unsigned)wid * 1024u;
  const int aoff = lds_byte(wr * 64 + fr, fq * 8), boff = lds_byte(wc * 32 + fr, fq * 8);
#define G_SA(b, h) (((b) * 2 + (h)) * HTB)
#define G_SB(b, h) ((4 + (b) * 2 + (h)) * HTB)
#define G_STAGE(bufoff, gbase, v0_, v1_) do { \
    __builtin_amdgcn_global_load_lds((const unsigned*)((const char*)(gbase) + (v0_)), (LAS unsigned*)(lds + (bufoff) + ldsw), 16, 0, 0); \
    __builtin_amdgcn_global_load_lds((const unsigned*)((const char*)(gbase) + (v1_)), (LAS unsigned*)(lds + (bufoff) + ldsw + 8192), 16, 0, 0); } while (0)
#define G_STAGEA(bufoff, gbase) G_STAGE(bufoff, gbase, voffA[0], voffA[1])
#define G_LDA(dst, b, h) do { _Pragma("unroll") for (int m = 0; m < 4; ++m) _Pragma("unroll") for (int k = 0; k < 2; ++k) dst[m][k] = *(const LAS bf16x8*)(lds + G_SA(b, h) + aoff + m * 2048 + k * 1024); } while (0)
#define G_LDB(dst, b, h) do { _Pragma("unroll") for (int n = 0; n < 2; ++n) _Pragma("unroll") for (int k = 0; k < 2; ++k) dst[n][k] = *(const LAS bf16x8*)(lds + G_SB(b, h) + boff + n * 2048 + k * 1024); } while (0)
#define G_MMA(ai, bj, At, Bt) do { __builtin_amdgcn_s_setprio(1); _Pragma("unroll") for (int m = 0; m < 4; ++m) _Pragma("unroll") for (int n = 0; n < 2; ++n) _Pragma("unroll") for (int k = 0; k < 2; ++k) \
    acc[ai][bj][m][n] = __builtin_amdgcn_mfma_f32_16x16x32_bf16(Bt[n][k], At[m][k], acc[ai][bj][m][n], 0, 0, 0); __builtin_amdgcn_s_setprio(0); } while (0)
#define G_WAIT_V(n) asm volatile("s_waitcnt vmcnt(" #n ")" ::: "memory")
#define G_WAIT_L(n) asm volatile("s_waitcnt lgkmcnt(" #n ")" ::: "memory")
#define G_BAR __builtin_amdgcn_s_barrier()
#define G_SCHED __builtin_amdgcn_sched_barrier(0)
  StaticOrder S; S.init(64, PH == 3 ? 4 : nN, gridDim.x, blockIdx.x);
  auto nextu = [&](int k, Unit& u) __attribute__((always_inline)) -> bool {
    if (PH == 3) { if (!S.next(k >> 1, u)) return false; u.pn += 4 * (k & 1); return true; }
    return S.next(k, u);
  };
  Unit cur, nxt; int ui = 0;
  if (!nextu(0, cur)) return;
  f32x4 acc[2][2][4][2];
#pragma unroll
  for (int a = 0; a < 2; ++a)
#pragma unroll
    for (int b = 0; b < 2; ++b)
#pragma unroll
      for (int m = 0; m < 4; ++m)
#pragma unroll
        for (int n = 0; n < 2; ++n) acc[a][b][m][n] = (f32x4){0.f, 0.f, 0.f, 0.f};
  bf16x8 At[4][2], B0[2][2], B1[2][2];
  const char* cA; const char* cB; int cvar;
  E.setup(cur, K, cA, cB, cvar);
  unsigned cv0 = voffB[0][0], cv1 = voffB[0][1]; size_t chB = hstepA;
  if (Epi<PH>::VARIANTS) { if (cvar == 1) { cv0 = voffB[NV > 1 ? 1 : 0][0]; cv1 = voffB[NV > 1 ? 1 : 0][1]; chB = (size_t)2 * K * 2; } else if (cvar == 2) { cv0 = voffB[NV > 2 ? 2 : 0][0]; cv1 = voffB[NV > 2 ? 2 : 0][1]; chB = (size_t)8 * K * 2; } }
  G_STAGE(G_SB(0, 0), cB, cv0, cv1); G_STAGEA(G_SA(0, 0), cA); G_STAGE(G_SB(0, 1), cB + chB, cv0, cv1); G_STAGEA(G_SA(0, 1), cA + hstepA);
  if (wr == 1) G_BAR;
  G_WAIT_V(4); G_BAR;
  G_STAGE(G_SB(1, 0), cB + kstep, cv0, cv1); G_STAGEA(G_SA(1, 0), cA + kstep); G_STAGE(G_SB(1, 1), cB + chB + kstep, cv0, cv1);
  G_WAIT_V(6); G_BAR;
  for (;;) {
    const bool has_next = nextu(ui + 1, nxt);
    const char* nA = cA; const char* nB = cB; int nvar = cvar;
    if (has_next) E.setup(nxt, K, nA, nB, nvar);
    unsigned nv0 = voffB[0][0], nv1 = voffB[0][1]; size_t nhB = hstepA;
    if (Epi<PH>::VARIANTS) { if (nvar == 1) { nv0 = voffB[NV > 1 ? 1 : 0][0]; nv1 = voffB[NV > 1 ? 1 : 0][1]; nhB = (size_t)2 * K * 2; } else if (nvar == 2) { nv0 = voffB[NV > 2 ? 2 : 0][0]; nv1 = voffB[NV > 2 ? 2 : 0][1]; nhB = (size_t)8 * K * 2; } }
    for (int t = 0; t < nt; t += 2) {
      const bool last = (t == nt - 2);
      if (Epi<PH>::HAS_MID && t == 16) E.mid(acc, cur, wr, wc, fr, fq);
      const char* a1 = cA + (size_t)(t + 1) * kstep;
      const char* a2 = last ? nA : cA + (size_t)(t + 2) * kstep; const char* b2 = last ? nB : cB + (size_t)(t + 2) * kstep;
      const char* a3 = a2 + kstep; const char* b3 = b2 + kstep;
      const unsigned bv0 = last ? nv0 : cv0, bv1 = last ? nv1 : cv1; const size_t bh = last ? nhB : chB;
      G_LDB(B0, 0, 0); G_SCHED; G_LDA(At, 0, 0); G_STAGEA(G_SA(1, 1), a1 + hstepA);
      G_WAIT_L(8); G_BAR; G_WAIT_L(0); G_MMA(0, 0, At, B0); G_BAR; G_SCHED;
      G_LDB(B1, 0, 1); G_STAGE(G_SB(0, 0), b2, bv0, bv1);
      G_BAR; G_WAIT_L(0); G_MMA(0, 1, At, B1); G_BAR;
      G_LDA(At, 0, 1); G_STAGEA(G_SA(0, 0), a2);
      G_BAR; G_WAIT_L(0); G_MMA(1, 0, At, B0); G_BAR; G_SCHED;
      G_STAGE(G_SB(0, 1), b2 + bh, bv0, bv1);
      G_WAIT_V(6); G_BAR; G_MMA(1, 1, At, B1); G_BAR;
      G_LDB(B0, 1, 0); G_SCHED; G_LDA(At, 1, 0); G_STAGEA(G_SA(0, 1), a2 + hstepA);
      G_WAIT_L(8); G_BAR; G_WAIT_L(0); G_MMA(0, 0, At, B0); G_BAR; G_SCHED;
      G_LDB(B1, 1, 1); G_STAGE(G_SB(1, 0), b3, bv0, bv1);
      G_BAR; G_WAIT_L(0); G_MMA(0, 1, At, B1); G_BAR;
      G_LDA(At, 1, 1); G_STAGEA(G_SA(1, 0), a3);
      G_BAR; G_WAIT_L(0); G_MMA(1, 0, At, B0); G_BAR; G_SCHED;
      G_STAGE(G_SB(1, 1), b3 + bh, bv0, bv1);
      G_WAIT_V(6); G_BAR; G_MMA(1, 1, At, B1); G_BAR;
    }
    E(acc, cur, wr, wc, fr, fq, lds);
    if (!has_next) break;
#pragma unroll
    for (int a = 0; a < 2; ++a)
#pragma unroll
      for (int b = 0; b < 2; ++b)
#pragma unroll
        for (int m = 0; m < 4; ++m)
#pragma unroll
          for (int n = 0; n < 2; ++n) acc[a][b][m][n] = (f32x4){0.f, 0.f, 0.f, 0.f};
    cur = nxt; cA = nA; cB = nB; cvar = nvar; cv0 = nv0; cv1 = nv1; chB = nhB; ++ui;
  }
  G_WAIT_V(0);
  if (wr == 0) G_BAR;
  G_BAR;
}

DI void gla_scan_item(const Params& p, LAS unsigned char* img, int item, int lane) {
  asm volatile("" : "+v"(lane));
  const int dvs = item & 7, dkt = (item >> 3) & 3, bh = item >> 5, b = bh >> 2, h = bh & 3;
  const int hh = lane >> 5, c = lane & 31;
  const char* ktb = (const char*)(P_KT(p) + ((size_t)b * 4096) * 512 + h * 128 + dkt * 32);
  const char* vab = (const char*)(P_VAT(p) + (size_t)(h * 256 + dvs * 32) * VAT_LD + (size_t)b * 4096);
  const char* blb = (const char*)(P_BL(p) + (size_t)(b * 64) * 512 + h * 128 + dkt * 32);
  const unsigned kto = (unsigned)(((lane >> 2) * 512 + (lane & 3) * 8) * 2), vao = (unsigned)((c * VAT_LD + 8 * hh) * 2), blo = (unsigned)(4 * hh * 4);
  u32x4* sf = (u32x4*)P_SFRAG(p) + (((size_t)(bh * 64) * 32 + dkt * 8 + dvs) * 64 + lane) * 2;
  const unsigned wbase = (unsigned)(size_t)img + (unsigned)((lane >> 2) * 64 + (lane & 3) * 16);
  const int i16 = lane & 15, q = i16 >> 2, pp = i16 & 3, blk = (lane >> 4) & 1;
  const unsigned rbase = (unsigned)(size_t)img + (unsigned)((8 * hh + q) * 64 + 8 * (4 * blk + pp));
  f32x16 S;
#pragma unroll
  for (int i = 0; i < 16; ++i) S[i] = 0.f;
  u32x4 kq0[4], kq1[4], kq2[4]; bf16x8 vq0[4], vq1[4], vq2[4]; f32x4 dq0[4], dq1[4], dq2[4];
  auto load_ops = [&](u32x4 (&kq)[4], bf16x8 (&vq)[4], f32x4 (&dq)[4], int n) __attribute__((always_inline)) {
#pragma unroll
    for (int e = 0; e < 4; ++e) {
      kq[e] = *(const u32x4*)(ktb + (size_t)(n * 64 + 16 * e) * 1024 + kto);
      vq[e] = *(const bf16x8*)(vab + (size_t)(n * 64 + 16 * e) * 2 + vao);
      dq[e] = *(const f32x4*)(blb + (size_t)(n * 512 + 8 * e) * 4 + blo);
    }
  };
  auto step = [&](u32x4 (&kq)[4], bf16x8 (&vq)[4], f32x4 (&dq)[4], int n) __attribute__((always_inline)) {
#pragma unroll
    for (int e = 0; e < 4; ++e) *(LAS u32x4*)(size_t)(wbase + e * 1024) = kq[e];
    {
      u32x4 w0, w1;
      w0.x = pk(S[0], S[1]); w0.y = pk(S[2], S[3]); w0.z = pk(S[4], S[5]); w0.w = pk(S[6], S[7]);
      w1.x = pk(S[8], S[9]); w1.y = pk(S[10], S[11]); w1.z = pk(S[12], S[13]); w1.w = pk(S[14], S[15]);
      u32x4* d = sf + (size_t)n * 4096; d[0] = w0; d[1] = w1;
    }
    s16x4 t0, t1, t2, t3, t4, t5, t6, t7;
    asm volatile("s_waitcnt lgkmcnt(0)\n\t"
                 "ds_read_b64_tr_b16 %0, %8\n\tds_read_b64_tr_b16 %1, %8 offset:256\n\t"
                 "ds_read_b64_tr_b16 %2, %8 offset:1024\n\tds_read_b64_tr_b16 %3, %8 offset:1280\n\t"
                 "ds_read_b64_tr_b16 %4, %8 offset:2048\n\tds_read_b64_tr_b16 %5, %8 offset:2304\n\t"
                 "ds_read_b64_tr_b16 %6, %8 offset:3072\n\tds_read_b64_tr_b16 %7, %8 offset:3328\n\t"
                 "s_waitcnt lgkmcnt(0)"
                 : "=&v"(t0), "=&v"(t1), "=&v"(t2), "=&v"(t3), "=&v"(t4), "=&v"(t5), "=&v"(t6), "=&v"(t7) : "v"(rbase) : "memory");
    f32x16 D, D2;
#pragma unroll
    for (int i = 0; i < 16; ++i) { D[i] = 0.f; D2[i] = 0.f; }
    D = MFMA32(cat4(t0, t1), vq[0], D); D2 = MFMA32(cat4(t4, t5), vq[2], D2); D = MFMA32(cat4(t2, t3), vq[1], D); D2 = MFMA32(cat4(t6, t7), vq[3], D2);
#pragma unroll
    for (int i = 0; i < 16; ++i) S[i] = (S[i] + (D[i] + D2[i])) * fast_exp(dq[i >> 2][i & 3]);
    if (n + 3 < 64) load_ops(kq, vq, dq, n + 3);
  };
  load_ops(kq0, vq0, dq0, 0); load_ops(kq1, vq1, dq1, 1); load_ops(kq2, vq2, dq2, 2);
#pragma unroll 1
  for (int n = 0; n < 63; n += 3) { step(kq0, vq0, dq0, n); step(kq1, vq1, dq1, n + 1); step(kq2, vq2, dq2, n + 2); }
  step(kq0, vq0, dq0, 63);
}

DI void gla_out_item(const Params& p, LAS unsigned char* wl, int item, int lane) {
  asm volatile("" : "+v"(lane));
  const int th = item & 1, n = (item >> 1) & 63, bh = item >> 7, b = bh >> 2, h = bh & 3;
  const int hh = lane >> 5, c = lane & 31;
  const size_t tok0 = (size_t)b * 4096 + n * 64;
  f32x16 o[8];
#pragma unroll
  for (int d = 0; d < 8; ++d)
#pragma unroll
    for (int i = 0; i < 16; ++i) o[d][i] = 0.f;
  const bf16_t* qrow = P_QT(p) + (tok0 + 32 * th + c) * 512 + h * 128;
  {
    bf16x8 qn[8];
#pragma unroll
    for (int s = 0; s < 8; ++s) qn[s] = *(const bf16x8*)(qrow + 16 * s + 8 * hh);
#pragma unroll 1
    for (int tt = 0; tt <= th; ++tt) {
      const bf16_t* vgl = P_VAT(p) + (size_t)(h * 256 + (lane >> 2)) * VAT_LD + tok0 + 32 * tt + (lane & 3) * 8;
      u32x4 vst0[8], vst1[8];
#pragma unroll
      for (int e = 0; e < 8; ++e) { vst0[e] = *(const u32x4*)(vgl + (size_t)(16 * e) * VAT_LD); vst1[e] = *(const u32x4*)(vgl + (size_t)(128 + 16 * e) * VAT_LD); }
      const bf16_t* krow = P_KT(p) + (tok0 + 32 * tt + c) * 512 + h * 128;
      f32x16 a;
#pragma unroll
      for (int i = 0; i < 16; ++i) a[i] = 0.f;
#pragma unroll
      for (int s = 0; s < 8; ++s) a = MFMA32(*(const bf16x8*)(krow + 16 * s + 8 * hh), qn[s], a);
#pragma unroll
      for (int i = 0; i < 16; ++i) a[i] = (32 * tt + crow(i, hh) > 32 * th + c) ? 0.f : a[i];
      const bf16x8 pf0 = pack8(a, 0), pf1 = pack8(a, 1);
      const unsigned vwr = (unsigned)(size_t)wl + (unsigned)((lane >> 2) * 80 + (lane & 3) * 16), vrd = (unsigned)(size_t)wl + (unsigned)(c * 80 + 8 * hh);
#pragma unroll
      for (int half = 0; half < 2; ++half) {
#pragma unroll
        for (int e = 0; e < 8; ++e) *(LAS u32x4*)(size_t)(vwr + e * 1280) = half ? vst1[e] : vst0[e];
        asm volatile("s_waitcnt lgkmcnt(0)" ::: "memory");
#pragma unroll
        for (int d4 = 0; d4 < 4; ++d4) {
          const unsigned va = vrd + d4 * 2560;
          o[4 * half + d4] = MFMA32(cat4(*(const LAS s16x4*)(size_t)(va), *(const LAS s16x4*)(size_t)(va + 16)), pf0, o[4 * half + d4]);
          o[4 * half + d4] = MFMA32(cat4(*(const LAS s16x4*)(size_t)(va + 32), *(const LAS s16x4*)(size_t)(va + 48)), pf1, o[4 * half + d4]);
        }
        asm volatile("s_waitcnt lgkmcnt(0)" ::: "memory");
      }
    }
  }
  const bf16_t* sfb = P_SFRAG(p) + ((size_t)(bh * 64 + n) * 32 * 64 + lane) * 16;
#pragma unroll 1
  for (int dkt = 0; dkt < 4; ++dkt) {
#pragma unroll
    for (int s = 0; s < 2; ++s) {
      const bf16_t* qp = qrow + 32 * dkt + 16 * s + 4 * hh;
      const bf16x8 qf = cat4(*(const s16x4*)qp, *(const s16x4*)(qp + 8));
#pragma unroll
      for (int dvt = 0; dvt < 8; ++dvt) o[dvt] = MFMA32(*(const bf16x8*)(sfb + (size_t)(dkt * 8 + dvt) * 1024 + 8 * s), qf, o[dvt]);
    }
  }
  float ss = 0.f;
#pragma unroll
  for (int d = 0; d < 8; ++d)
#pragma unroll
    for (int i = 0; i < 16; ++i) ss += o[d][i] * o[d][i];
  ss += __shfl_xor(ss, 32);
  const float rstd = __builtin_amdgcn_rsqf(ss * (1.0f / 256.0f) + 1e-6f);
  const unsigned ow = (unsigned)(size_t)wl + (unsigned)(c * 528 + 8 * hh);
#pragma unroll
  for (int dvt = 0; dvt < 8; ++dvt)
#pragma unroll
    for (int g = 0; g < 4; ++g) {
      const int dv = 32 * dvt + 8 * g + 4 * hh; const f32x4 gn = *(const f32x4*)(p.gla_gain + dv);
      u32x2 w; w.x = pk(o[dvt][4 * g + 0] * rstd * gn[0], o[dvt][4 * g + 1] * rstd * gn[1]); w.y = pk(o[dvt][4 * g + 2] * rstd * gn[2], o[dvt][4 * g + 3] * rstd * gn[3]);
      *(LAS u32x2*)(size_t)(ow + (32 * dvt + 8 * g) * 2) = w;
    }
  asm volatile("s_waitcnt lgkmcnt(0)" ::: "memory");
  bf16_t* obase = P_A2(p) + (tok0 + 32 * th) * 1536 + h * 256 + (lane & 31) * 8;
#pragma unroll
  for (int e = 0; e < 16; ++e) {
    const int row = (lane >> 5) + 2 * e;
    const u32x4 w = *(const LAS u32x4*)(size_t)((unsigned)(size_t)wl + (unsigned)(row * 528 + (lane & 31) * 16));
    *(u32x4*)(obase + (size_t)row * 1536) = w;
  }
  asm volatile("s_waitcnt lgkmcnt(0)" ::: "memory");
}

template <bool MERGE>
DI void attn_group_item(const Params& p, LAS unsigned char* wl, int item, int lane, const int g) {
  asm volatile("" : "+v"(lane));
  const int lg = 2 * g, L = 4096 >> lg, njl = 7 - lg;
  const int j = item & ((1 << njl) - 1), r = (item >> njl) & ((1 << lg) - 1), h4 = (item >> 7) & 3, b = item >> 9;
  const int hh = lane >> 5, c = lane & 31, head = 4 * g + h4;
  const int ui = 32 * j + c;
  const size_t plane = (size_t)(b * 12 + head) * 4096;
  const bf16_t* qrow = P_QD(p) + (plane + r * L + ui) * 128 + 8 * hh;
  bf16x8 qf[8];
#pragma unroll
  for (int s = 0; s < 8; ++s) qf[s] = *(const bf16x8*)(qrow + 16 * s);
  const bf16_t* kg = P_KD(p) + (plane + r * L) * 128 + lane * 8;
  const bf16_t* vg = P_VDT(p) + ((size_t)(b * 12 + head) * 128 + (lane >> 2)) * VDT_LD + r * L + (lane & 3) * 8;
  const unsigned kw = (unsigned)(size_t)wl + (unsigned)((lane >> 4) * 272 + (lane & 15) * 16);
  const unsigned vw = (unsigned)(size_t)wl + 8704u + (unsigned)((lane >> 2) * 80 + (lane & 3) * 16);
  const unsigned kr = (unsigned)(size_t)wl + (unsigned)(c * 272 + 16 * hh);
  const unsigned vr = (unsigned)(size_t)wl + 8704u + (unsigned)(c * 80 + 8 * hh);
  const int kt0 = j >= 4 ? j - 4 : 0;
  u32x4 kst[8], vst[8];
#pragma unroll
  for (int e = 0; e < 8; ++e) { kst[e] = *(const u32x4*)(kg + (size_t)(32 * kt0) * 128 + e * 512); vst[e] = *(const u32x4*)(vg + (size_t)(e * 16) * VDT_LD + 32 * kt0); }
  f32x16 o[4];
#pragma unroll
  for (int d = 0; d < 4; ++d)
#pragma unroll
    for (int i = 0; i < 16; ++i) o[d][i] = 0.f;
  float m_run = -1e30f, l_run = 0.f;
#pragma unroll 1
  for (int kt = kt0; kt <= j; ++kt) {
#pragma unroll
    for (int e = 0; e < 8; ++e) { *(LAS u32x4*)(size_t)(kw + e * 1088) = kst[e]; *(LAS u32x4*)(size_t)(vw + e * 1280) = vst[e]; }
    if (kt < j) {
#pragma unroll
      for (int e = 0; e < 8; ++e) { kst[e] = *(const u32x4*)(kg + (size_t)(32 * (kt + 1)) * 128 + e * 512); vst[e] = *(const u32x4*)(vg + (size_t)(e * 16) * VDT_LD + 32 * (kt + 1)); }
    }
    asm volatile("s_waitcnt lgkmcnt(0)" ::: "memory");
    f32x16 sa, sb;
#pragma unroll
    for (int i = 0; i < 16; ++i) { sa[i] = 0.f; sb[i] = 0.f; }
#pragma unroll
    for (int s = 0; s < 4; ++s) { sa = MFMA32(*(const LAS bf16x8*)(size_t)(kr + 32 * s), qf[s], sa); sb = MFMA32(*(const LAS bf16x8*)(size_t)(kr + 32 * (s + 4)), qf[s + 4], sb); }
    float tmax = -1e30f;
    const bool interior = (kt >= j - 3) && (kt < j);
    if (interior) {
#pragma unroll
      for (int i = 0; i < 16; ++i) { const float sv = (sa[i] + sb[i]) * 0.12751743074602467f; sa[i] = sv; tmax = fmaxf(tmax, sv); }
    } else {
#pragma unroll
      for (int i = 0; i < 16; ++i) { const int key = 32 * kt + crow(i, hh); const bool valid = (key <= ui) && (key >= ui - 128); const float sv = valid ? (sa[i] + sb[i]) * 0.12751743074602467f : -1e30f; sa[i] = sv; tmax = fmaxf(tmax, sv); }
    }
    tmax = fmaxf(tmax, __shfl_xor(tmax, 32));
    const float m_new = fmaxf(m_run, tmax), alpha = __builtin_amdgcn_exp2f(m_run - m_new);
    float psum = 0.f;
    if (interior) {
#pragma unroll
      for (int i = 0; i < 16; ++i) { const float pv = __builtin_amdgcn_exp2f(sa[i] - m_new); psum += pv; sa[i] = pv; }
    } else {
#pragma unroll
      for (int i = 0; i < 16; ++i) { const float pv = (sa[i] > -1e29f) ? __builtin_amdgcn_exp2f(sa[i] - m_new) : 0.f; psum += pv; sa[i] = pv; }
    }
    psum += __shfl_xor(psum, 32);
    l_run = l_run * alpha + psum; m_run = m_new;
    if (__builtin_amdgcn_ballot_w64(alpha != 1.0f)) {
#pragma unroll
      for (int d = 0; d < 4; ++d)
#pragma unroll
        for (int i = 0; i < 16; ++i) o[d][i] *= alpha;
    }
    const bf16x8 pf0 = pack8(sa, 0), pf1 = pack8(sa, 1);
#pragma unroll
    for (int dt = 0; dt < 4; ++dt) {
      const unsigned va = vr + dt * 2560;
      o[dt] = MFMA32(cat4(*(const LAS s16x4*)(size_t)(va), *(const LAS s16x4*)(size_t)(va + 16)), pf0, o[dt]);
      o[dt] = MFMA32(cat4(*(const LAS s16x4*)(size_t)(va + 32), *(const LAS s16x4*)(size_t)(va + 48)), pf1, o[dt]);
    }
    asm volatile("s_waitcnt lgkmcnt(0)" ::: "memory");
  }
  const float inv = __builtin_amdgcn_rcpf(l_run);
  const float lse = 0.6931471805599453f * (m_run + __builtin_amdgcn_logf(l_run));
  const size_t token = (size_t)b * 4096 + r + ((size_t)ui << lg);
  if (!MERGE) {
    if (hh == 0) (g == 0 ? P_LSE0(p) : (g == 1 ? P_LSE1(p) : P_LSE2(p)))[token * 4 + h4] = lse;
    const unsigned ow = (unsigned)(size_t)wl + (unsigned)(c * 272 + 8 * hh);
#pragma unroll
    for (int dt = 0; dt < 4; ++dt)
#pragma unroll
      for (int q = 0; q < 4; ++q) {
        u32x2 w; w.x = pk(o[dt][4 * q + 0] * inv, o[dt][4 * q + 1] * inv); w.y = pk(o[dt][4 * q + 2] * inv, o[dt][4 * q + 3] * inv);
        *(LAS u32x2*)(size_t)(ow + (32 * dt + 8 * q) * 2) = w;
      }
    asm volatile("s_waitcnt lgkmcnt(0)" ::: "memory");
    bf16_t* obase = (g == 0 ? P_OG0(p) : (g == 1 ? P_OG1(p) : P_OG2(p))) + 128 * h4 + (lane & 15) * 8;
    const size_t tok0 = (size_t)b * 4096 + r + ((size_t)(32 * j) << lg);
#pragma unroll
    for (int e = 0; e < 8; ++e) {
      const int row = (lane >> 4) + 4 * e;
      const u32x4 w = *(const LAS u32x4*)(size_t)((unsigned)(size_t)wl + (unsigned)(row * 272 + (lane & 15) * 16));
      *(u32x4*)(obase + (tok0 + ((size_t)row << lg)) * 512) = w;
    }
    asm volatile("s_waitcnt lgkmcnt(0)" ::: "memory");
  } else {
    const float l0 = P_LSE0(p)[token * 4 + h4], l1 = P_LSE1(p)[token * 4 + h4];
    const float mx = fmaxf(fmaxf(l0, l1), lse);
    float w0 = fast_exp(l0 - mx), w1 = fast_exp(l1 - mx), w2 = fast_exp(lse - mx);
    const float wi = __builtin_amdgcn_rcpf(w0 + w1 + w2); w0 *= wi; w1 *= wi; w2 *= wi * inv;
    const bf16_t* o0 = P_OG0(p) + token * 512 + 128 * h4; const bf16_t* o1 = P_OG1(p) + token * 512 + 128 * h4;
    const bf16_t* zrow = P_ZD(p) + token * 512 + 128 * h4;
    bf16_t* orow = P_A2(p) + token * 1536 + 1024 + 128 * h4;
#pragma unroll
    for (int dt = 0; dt < 4; ++dt)
#pragma unroll
      for (int q = 0; q < 4; ++q) {
        const int d = 32 * dt + 8 * q + 4 * hh;
        const u32x2 z = *(const u32x2*)(zrow + d), a0 = *(const u32x2*)(o0 + d), a1 = *(const u32x2*)(o1 + d);
        const float r0 = (w0 * bf_lo(a0.x) + w1 * bf_lo(a1.x) + w2 * o[dt][4 * q + 0]) * bf_lo(z.x);
        const float r1 = (w0 * bf_hi(a0.x) + w1 * bf_hi(a1.x) + w2 * o[dt][4 * q + 1]) * bf_hi(z.x);
        const float r2 = (w0 * bf_lo(a0.y) + w1 * bf_lo(a1.y) + w2 * o[dt][4 * q + 2]) * bf_lo(z.y);
        const float r3 = (w0 * bf_hi(a0.y) + w1 * bf_hi(a1.y) + w2 * o[dt][4 * q + 3]) * bf_hi(z.y);
        u32x2 w; w.x = pk(r0, r1); w.y = pk(r2, r3);
        *(u32x2*)(orow + d) = w;
      }
  }
}

DI void attn_merge_pass(const Params& p, const int wid, int lane) {
  asm volatile("" : "+v"(lane));
  const int gw = blockIdx.x * 8 + wid, nw = gridDim.x * 8;
#pragma unroll 2
  for (int q = gw * 64 + lane; q < 65536 * 16; q += nw * 64) {
    const int R = q >> 4, dq = (q & 15) * 8;
    const float l0 = P_LSE0(p)[R], l1 = P_LSE1(p)[R], l2 = P_LSE2(p)[R];
    const u32x4 a0 = *(const u32x4*)(P_OG0(p) + (size_t)q * 8), a1 = *(const u32x4*)(P_OG1(p) + (size_t)q * 8), a2 = *(const u32x4*)(P_OG2(p) + (size_t)q * 8), z = *(const u32x4*)(P_ZD(p) + (size_t)q * 8);
    const float mx = fmaxf(fmaxf(l0, l1), l2);
    float w0 = fast_exp(l0 - mx), w1 = fast_exp(l1 - mx), w2 = fast_exp(l2 - mx);
    const float wi = __builtin_amdgcn_rcpf(w0 + w1 + w2); w0 *= wi; w1 *= wi; w2 *= wi;
    u32x4 w;
    w.x = pk((w0 * bf_lo(a0.x) + w1 * bf_lo(a1.x) + w2 * bf_lo(a2.x)) * bf_lo(z.x), (w0 * bf_hi(a0.x) + w1 * bf_hi(a1.x) + w2 * bf_hi(a2.x)) * bf_hi(z.x));
    w.y = pk((w0 * bf_lo(a0.y) + w1 * bf_lo(a1.y) + w2 * bf_lo(a2.y)) * bf_lo(z.y), (w0 * bf_hi(a0.y) + w1 * bf_hi(a1.y) + w2 * bf_hi(a2.y)) * bf_hi(z.y));
    w.z = pk((w0 * bf_lo(a0.z) + w1 * bf_lo(a1.z) + w2 * bf_lo(a2.z)) * bf_lo(z.z), (w0 * bf_hi(a0.z) + w1 * bf_hi(a1.z) + w2 * bf_hi(a2.z)) * bf_hi(z.z));
    w.w = pk((w0 * bf_lo(a0.w) + w1 * bf_lo(a1.w) + w2 * bf_lo(a2.w)) * bf_lo(z.w), (w0 * bf_hi(a0.w) + w1 * bf_hi(a1.w) + w2 * bf_hi(a2.w)) * bf_hi(z.w));
    *(u32x4*)(P_A2(p) + (size_t)(R >> 2) * 1536 + 1024 + (R & 3) * 128 + dq) = w;
  }
}

__global__ void __launch_bounds__(512) hybrid_fwd(Params p) {
  cg::grid_group grid = cg::this_grid();
  __shared__ __attribute__((aligned(1024))) unsigned char smem[151552 + 16];
  LAS unsigned char* lds = (LAS unsigned char*)smem;
  const int wid = __builtin_amdgcn_readfirstlane(threadIdx.x >> 6);
  volatile LAS unsigned* xst = (volatile LAS unsigned*)(lds + 151552);
  if (wid == 0 && lane_id() == 0) { xst[0] = 0u; xst[1] = 0u; }
  __syncthreads();
  const XcdBarrier xb = xcd_barrier_post(P_CNT(p), xst, wid == 0 && lane_id() == 0);
  phase0(p, lds, wid);
  if (p.ws == nullptr) grid.sync();
  xcd_barrier(xb, wid);
  { Epi<1> E; E.p = p; gemm_phase<1>(lds, 1024, 8, E, wid); }
  xcd_barrier(xb, wid);
  {
    if (wid < 2) {
      if (gridDim.x == 256) { const int xcd = blockIdx.x & 7, slot = blockIdx.x >> 3; gla_scan_item(p, lds + wid * 4096, (xcd + 8 * (slot >> 4)) * 32 + (slot & 15) * 2 + wid, lane_id()); }
      else for (int item = blockIdx.x * 2 + wid; item < 512; item += gridDim.x * 2) gla_scan_item(p, lds + wid * 4096, item, lane_id());
    }
    else {
      for (int idx = blockIdx.x * 6 + (wid - 2); idx < 5376; idx += gridDim.x * 6) conv_wave_tile(p, lds + 8192 + (wid - 2) * 8704, idx, lane_id());
      for (int c = blockIdx.x; c < 256; c += gridDim.x) rope_chunk(p, c, (wid - 2) * 64 + lane_id());
    }
  }
  xcd_barrier(xb, wid);
  for (int item = blockIdx.x * 8 + wid; item < 2048; item += gridDim.x * 8) gla_out_item(p, lds + wid * 16896, item, lane_id());
  xcd_barrier(xb, wid);
  { Epi<2> E; E.p = p; gemm_phase<2>(lds, 1024, 24, E, wid); }
  xcd_barrier(xb, wid);
  {
    const int bperm = (gridDim.x == 256) ? (((int)blockIdx.x & 7) * 32 + ((int)blockIdx.x >> 3)) : (int)blockIdx.x;
    for (int idx = bperm * 8 + wid; idx < 6144; idx += gridDim.x * 8) attn_group_item<false>(p, lds + wid * 18944, idx & 2047, lane_id(), idx >> 11);
  }
  xcd_barrier(xb, wid);
  attn_merge_pass(p, wid, lane_id());
  xcd_barrier(xb, wid);
  { Epi<3> E; E.p = p; gemm_phase<3>(lds, 1024, 8, E, wid); }
  asm volatile("s_waitcnt vmcnt(0)" ::: "memory"); __syncthreads();
  { Epi<4> E; E.p = p; gemm_phase<4>(lds, 1536, 4, E, wid); }
  xcd_barrier(xb, wid);
  { Epi<5> E; E.p = p; gemm_phase<5>(lds, 1024, 4, E, wid); }
}

extern "C" void kernel_launch(void* const* d_in, const int* in_sizes, int n_in, void* d_out, int out_size, void* d_ws, size_t ws_size, hipStream_t stream) {
  static int grid_blocks = 0;
  if (!grid_blocks) {
    int dev = 0, cus = 0, per_cu = 0;
    (void)hipGetDevice(&dev);
    (void)hipDeviceGetAttribute(&cus, hipDeviceAttributeMultiprocessorCount, dev);
    (void)hipOccupancyMaxActiveBlocksPerMultiprocessor(&per_cu, hybrid_fwd, 512, 0);
    if (per_cu < 1) per_cu = 1;
    grid_blocks = cus * (per_cu > 1 ? 1 : per_cu);
  }
  Params p{};
  p.x = (const float*)d_in[0]; p.pos = (const int*)d_in[1]; p.norm_gain = (const float*)d_in[2]; p.w_in = (const float*)d_in[3];
  p.w_a2 = (const float*)d_in[4]; p.b_a = (const float*)d_in[5]; p.gla_gain = (const float*)d_in[6]; p.qg = (const float*)d_in[7]; p.kg = (const float*)d_in[8];
  p.w_go = (const float*)d_in[9]; p.w_do = (const float*)d_in[10]; p.w_o = (const float*)d_in[11];
  p.ws = (unsigned char*)d_ws; p.out = (unsigned char*)d_out;
  (void)hipMemsetAsync((unsigned char*)d_ws + MB(43) + 786432, 0, 16384, stream);
  void* args[] = {&p};
  (void)hipLaunchCooperativeKernel((void*)hybrid_fwd, dim3(grid_blocks), dim3(512), args, 0, stream);
}
```
